# Optimizing an MI355X kernel written in HIP

```python
import math, functools
import jax, jax.numpy as jnp
from jax import lax
import numpy as np

D_MODEL = 1024
BATCH = 8
SEQ = 2048
DEPTH = 4
DEC_BATCH = 128
DEC_SEQ = 8
PAST_LEN = 8192
PAGE_SIZE = 128

HEAD_DIM = 64
ATTN_W = D_MODEL // 2
N_Q_HEADS = ATTN_W // HEAD_DIM
N_KV_HEADS = N_Q_HEADS // 4
Q_GROUP = N_Q_HEADS // N_KV_HEADS
KV_W = N_KV_HEADS * HEAD_DIM
WINDOW = 128
BLOCK = 128
ROT_DIM = HEAD_DIM // 4
ROPE_THETA = 500000.0
SSM_W = D_MODEL - ATTN_W
SSM_GROUP_CH = 16
N_SSM_GROUPS = SSM_W // SSM_GROUP_CH
SSM_STATE = 64
DT_MIN = 1e-3
DT_MAX = 1e-1
MIX_W = ATTN_W + SSM_W
IN_W = ATTN_W + 2 * KV_W + ATTN_W + 2 * SSM_W
SPLIT_IDX = (ATTN_W, ATTN_W + KV_W, ATTN_W + 2 * KV_W, 2 * ATTN_W + 2 * KV_W,
             2 * ATTN_W + 2 * KV_W + SSM_W)
EPS = 1e-6
NEG_INF = -1e30

kernel_name = "hymba_swa_sink_s5_adaln_step"


def rms_norm(x, g):
    xf = x.astype(jnp.float32)
    y = xf * lax.rsqrt(jnp.mean(xf * xf, axis=-1, keepdims=True) + EPS)
    return (y * g.astype(jnp.float32)).astype(x.dtype)


def rope_partial(x, pos):
    half = ROT_DIM // 2
    inv = ROPE_THETA ** (-jnp.arange(half, dtype=jnp.float32) / half)
    ang = pos.astype(jnp.float32)[:, None] * inv[None, :]
    cos = jnp.cos(ang)[:, None, :].astype(x.dtype)
    sin = jnp.sin(ang)[:, None, :].astype(x.dtype)
    x1 = x[..., :half]
    x2 = x[..., half:ROT_DIM]
    return jnp.concatenate([x1 * cos - x2 * sin, x2 * cos + x1 * sin, x[..., ROT_DIM:]], axis=-1)


def sink_attention(q, k, v, mask, sinks):
    s = jnp.einsum('...qhgd,...khd->...hgqk', q, k).astype(jnp.float32) * (HEAD_DIM ** -0.5)
    s = jnp.where(mask, s, NEG_INF)
    sink = sinks.astype(jnp.float32).reshape(N_KV_HEADS, Q_GROUP)[:, :, None, None]
    m = jnp.maximum(jnp.max(s, axis=-1, keepdims=True), sink)
    p = jnp.exp(s - m)
    p = p / (jnp.sum(p, axis=-1, keepdims=True) + jnp.exp(sink - m))
    return jnp.einsum('...hgqk,...khd->...qhgd', p.astype(v.dtype), v)


def attend_prompt(q, k, v, sinks):
    Bn, L = q.shape[0], q.shape[1]
    nb = L // BLOCK
    qb = q.reshape(Bn, nb, BLOCK, N_KV_HEADS, Q_GROUP, HEAD_DIM)
    kb = k.reshape(Bn, nb, BLOCK, N_KV_HEADS, HEAD_DIM)
    vb = v.reshape(Bn, nb, BLOCK, N_KV_HEADS, HEAD_DIM)
    kk = jnp.concatenate([jnp.concatenate([jnp.zeros_like(kb[:, :1]), kb[:, :-1]], axis=1), kb], axis=2)
    vv = jnp.concatenate([jnp.concatenate([jnp.zeros_like(vb[:, :1]), vb[:, :-1]], axis=1), vb], axis=2)
    blk = jnp.arange(nb)[:, None]
    qpos = blk * BLOCK + jnp.arange(BLOCK)[None, :]
    kpos = (blk - 1) * BLOCK + jnp.arange(2 * BLOCK)[None, :]
    diff = qpos[:, :, None] - kpos[:, None, :]
    mask = (diff >= 0) & (diff <= WINDOW) & (kpos[:, None, :] >= 0)
    out = sink_attention(qb, kk, vv, mask[:, None, None], sinks)
    return out.reshape(Bn, L, ATTN_W)


def attend_sample(buf_k, buf_v, q, k, v, sinks):
    Bn, T = q.shape[0], q.shape[1]
    w = buf_k.shape[1]
    kk = jnp.concatenate([buf_k.astype(k.dtype), k], axis=1)
    vv = jnp.concatenate([buf_v.astype(v.dtype), v], axis=1)
    qpos = PAST_LEN + jnp.arange(T)
    kpos = PAST_LEN - w + jnp.arange(w + T)
    diff = qpos[:, None] - kpos[None, :]
    mask = (diff >= 0) & (diff <= WINDOW)
    qg = q.reshape(Bn, T, N_KV_HEADS, Q_GROUP, HEAD_DIM)
    out = sink_attention(qg, kk, vv, mask, sinks)
    return out.reshape(Bn, T, ATTN_W)


def complex_scan_combine(e1, e2):
    a1r, a1i, b1r, b1i = e1
    a2r, a2i, b2r, b2i = e2
    ar = a1r * a2r - a1i * a2i
    ai = a1r * a2i + a1i * a2r
    br = a2r * b1r - a2i * b1i + b2r
    bi = a2r * b1i + a2i * b1r + b2i
    return (ar, ai, br, bi)


def s5_branch(u, h0_re, h0_im, a_re, a_im, log_dt, b_re, b_im, c_re, c_im, d, w_glu, b_glu):
    f32 = jnp.float32
    Bn, L = u.shape[0], u.shape[1]
    uf = u.astype(f32).reshape(Bn, L, N_SSM_GROUPS, SSM_GROUP_CH)
    a_re = a_re.astype(f32)
    a_im = a_im.astype(f32)
    dt = jnp.exp(log_dt.astype(f32))[:, None]
    mag = jnp.exp(a_re * dt)
    abar_re = mag * jnp.cos(a_im * dt)
    abar_im = mag * jnp.sin(a_im * dt)
    den = a_re * a_re + a_im * a_im
    nr = abar_re - 1.0
    coef_re = (nr * a_re + abar_im * a_im) / den
    coef_im = (abar_im * a_re - nr * a_im) / den
    br = b_re.astype(f32)
    bi = b_im.astype(f32)
    bb_re = coef_re[..., None] * br - coef_im[..., None] * bi
    bb_im = coef_re[..., None] * bi + coef_im[..., None] * br
    bu_re = jnp.einsum('gpc,blgc->blgp', bb_re, uf)
    bu_im = jnp.einsum('gpc,blgc->blgp', bb_im, uf)
    a_seq_re = jnp.broadcast_to(abar_re, (1, L, N_SSM_GROUPS, SSM_STATE))
    a_seq_im = jnp.broadcast_to(abar_im, (1, L, N_SSM_GROUPS, SSM_STATE))
    acum_re, acum_im, hz_re, hz_im = lax.associative_scan(
        complex_scan_combine, (a_seq_re, a_seq_im, bu_re, bu_im), axis=1)
    s_re = h0_re.astype(f32)[:, None]
    s_im = h0_im.astype(f32)[:, None]
    h_re = hz_re + acum_re * s_re - acum_im * s_im
    h_im = hz_im + acum_re * s_im + acum_im * s_re
    y = (jnp.einsum('gcp,blgp->blgc', c_re.astype(f32), h_re)
         - jnp.einsum('gcp,blgp->blgc', c_im.astype(f32), h_im)
         + d.astype(f32) * uf)
    y = jax.nn.gelu(y.reshape(Bn, L, SSM_W))
    y = y * jax.nn.sigmoid(y @ w_glu.astype(f32) + b_glu.astype(f32))
    return y.astype(u.dtype), h_re[:, -1].astype(h0_re.dtype), h_im[:, -1].astype(h0_im.dtype)


def decoder_layer(x, c, pos, attend, h0_re, h0_im, norm_g, w_ada, b_ada, w_in, sinks,
                  a_re, a_im, log_dt, b_re, b_im, c_re, c_im, d, w_glu, b_glu, w_out):
    Bn, L = x.shape[0], x.shape[1]
    mod = jax.nn.silu(c) @ w_ada + b_ada
    shift, scale, gate = jnp.split(mod[:, None, :], 3, axis=-1)
    h = rms_norm(x, norm_g) * (1.0 + scale) + shift
    proj = h @ w_in
    q, k, v, za, u, zs = jnp.split(proj, SPLIT_IDX, axis=-1)
    q = rope_partial(q.reshape(Bn, L, N_Q_HEADS, HEAD_DIM), pos)
    k = rope_partial(k.reshape(Bn, L, N_KV_HEADS, HEAD_DIM), pos)
    v = v.reshape(Bn, L, N_KV_HEADS, HEAD_DIM)
    ya = attend(q, k, v, sinks)
    ys, hT_re, hT_im = s5_branch(u, h0_re, h0_im, a_re, a_im, log_dt, b_re, b_im,
                                 c_re, c_im, d, w_glu, b_glu)
    mix = jnp.concatenate([ya * jax.nn.silu(za), ys * jax.nn.silu(zs)], axis=-1)
    x = x + gate * (mix @ w_out)
    return x, k, v, hT_re, hT_im


def setup_inputs(seed: int = 0) -> dict:
    key = jax.random.key(seed)
    ks = jax.random.split(key, 26)
    f32 = jnp.float32
    win_buf = min(WINDOW, PAST_LEN)
    nrm = lambda k, s: jax.random.normal(k, s, f32)
    return {
        "x_prompt": nrm(ks[0], (BATCH, SEQ, D_MODEL)),
        "x_sample": nrm(ks[1], (DEC_BATCH, DEC_SEQ, D_MODEL)),
        "cache_k": nrm(ks[2], (DEPTH, DEC_BATCH, win_buf, N_KV_HEADS, HEAD_DIM)),
        "cache_v": nrm(ks[3], (DEPTH, DEC_BATCH, win_buf, N_KV_HEADS, HEAD_DIM)),
        "state_ssm_re": 0.3 * nrm(ks[4], (DEPTH, DEC_BATCH, N_SSM_GROUPS, SSM_STATE)),
        "state_ssm_im": 0.3 * nrm(ks[5], (DEPTH, DEC_BATCH, N_SSM_GROUPS, SSM_STATE)),
        "c_prompt": nrm(ks[6], (BATCH, D_MODEL)),
        "c_sample": nrm(ks[7], (DEC_BATCH, D_MODEL)),
        "norm_g": 1.0 + 0.05 * nrm(ks[8], (DEPTH, D_MODEL)),
        "w_ada": 0.3 * D_MODEL ** -0.5 * nrm(ks[9], (DEPTH, D_MODEL, 3 * D_MODEL)),
        "b_ada": 0.01 * nrm(ks[10], (DEPTH, 3 * D_MODEL)),
        "w_in": D_MODEL ** -0.5 * nrm(ks[11], (DEPTH, D_MODEL, IN_W)),
        "attn_sinks": 0.5 * nrm(ks[12], (DEPTH, N_Q_HEADS)),
        "ssm_a_re": -0.5 + 0.01 * nrm(ks[13], (DEPTH, N_SSM_GROUPS, SSM_STATE)),
        "ssm_a_im": math.pi * jnp.arange(SSM_STATE, dtype=f32)
                    + 0.01 * nrm(ks[14], (DEPTH, N_SSM_GROUPS, SSM_STATE)),
        "ssm_log_dt": jax.random.uniform(ks[15], (DEPTH, N_SSM_GROUPS), f32,
                                         math.log(DT_MIN), math.log(DT_MAX)),
        "ssm_b_re": (2 * SSM_GROUP_CH) ** -0.5 * nrm(ks[16], (DEPTH, N_SSM_GROUPS, SSM_STATE, SSM_GROUP_CH)),
        "ssm_b_im": (2 * SSM_GROUP_CH) ** -0.5 * nrm(ks[17], (DEPTH, N_SSM_GROUPS, SSM_STATE, SSM_GROUP_CH)),
        "ssm_c_re": SSM_STATE ** -0.5 * nrm(ks[18], (DEPTH, N_SSM_GROUPS, SSM_GROUP_CH, SSM_STATE)),
        "ssm_c_im": SSM_STATE ** -0.5 * nrm(ks[19], (DEPTH, N_SSM_GROUPS, SSM_GROUP_CH, SSM_STATE)),
        "ssm_d": nrm(ks[20], (DEPTH, N_SSM_GROUPS, SSM_GROUP_CH)),
        "w_glu": SSM_W ** -0.5 * nrm(ks[21], (DEPTH, SSM_W, SSM_W)),
        "b_glu": 0.01 * nrm(ks[22], (DEPTH, SSM_W)),
        "w_out": MIX_W ** -0.5 * nrm(ks[23], (DEPTH, MIX_W, D_MODEL)),
        "final_g": 1.0 + 0.05 * nrm(ks[24], (D_MODEL,)),
    }


def reference(x_prompt, x_sample, cache_k, cache_v, state_ssm_re, state_ssm_im, c_prompt, c_sample,
              norm_g, w_ada, b_ada, w_in, attn_sinks, ssm_a_re, ssm_a_im, ssm_log_dt,
              ssm_b_re, ssm_b_im, ssm_c_re, ssm_c_im, ssm_d, w_glu, b_glu, w_out, final_g):
    win_buf = cache_k.shape[2]
    pos_p = jnp.arange(x_prompt.shape[1])
    pos_s = PAST_LEN + jnp.arange(x_sample.shape[1])
    zeros_state = jnp.zeros((x_prompt.shape[0], N_SSM_GROUPS, SSM_STATE), x_prompt.dtype)
    xp, xs = x_prompt, x_sample
    kp_l, vp_l, srp_l, sip_l = [], [], [], []
    ks_l, vs_l, srs_l, sis_l = [], [], [], []
    for l in range(DEPTH):
        params = (norm_g[l], w_ada[l], b_ada[l], w_in[l], attn_sinks[l], ssm_a_re[l], ssm_a_im[l],
                  ssm_log_dt[l], ssm_b_re[l], ssm_b_im[l], ssm_c_re[l], ssm_c_im[l], ssm_d[l],
                  w_glu[l], b_glu[l], w_out[l])
        xp, kp, vp, hr, hi = decoder_layer(xp, c_prompt, pos_p, attend_prompt,
                                           zeros_state, zeros_state, *params)
        kp_l.append(kp[:, -win_buf:])
        vp_l.append(vp[:, -win_buf:])
        srp_l.append(hr)
        sip_l.append(hi)
        att_s = functools.partial(attend_sample, cache_k[l], cache_v[l])
        xs, kn, vn, hr_s, hi_s = decoder_layer(xs, c_sample, pos_s, att_s,
                                               state_ssm_re[l], state_ssm_im[l], *params)
        ks_l.append(jnp.concatenate([cache_k[l].astype(kn.dtype), kn], axis=1)[:, -win_buf:])
        vs_l.append(jnp.concatenate([cache_v[l].astype(vn.dtype), vn], axis=1)[:, -win_buf:])
        srs_l.append(hr_s)
        sis_l.append(hi_s)
    y_prompt = rms_norm(xp, final_g)
    y_sample = rms_norm(xs, final_g)
    new_k_prompt = jnp.stack(kp_l)
    new_v_prompt = jnp.stack(vp_l)
    new_ssm_re_prompt = jnp.stack(srp_l)
    new_ssm_im_prompt = jnp.stack(sip_l)
    new_k_sample = jnp.stack(ks_l)
    new_v_sample = jnp.stack(vs_l)
    new_ssm_re_sample = jnp.stack(srs_l)
    new_ssm_im_sample = jnp.stack(sis_l)
    return (y_prompt, y_sample, new_k_prompt, new_v_prompt, new_ssm_re_prompt, new_ssm_im_prompt,
            new_k_sample, new_v_sample, new_ssm_re_sample, new_ssm_im_sample)
```

```cpp
#include <hip/hip_runtime.h>
#include <hip/hip_cooperative_groups.h>
#include <cstdio>
namespace cg = cooperative_groups;


#define USE_XCC_MAP 0
#define REP_PREP 1
#define REP_MOD 1
#define REP_NORM 1
#define REP_INPROJ 1
#define REP_ATTN 1
#define REP_GLU 1
#define REP_OUT0 1
typedef unsigned short u16;
using bf16x8 = __attribute__((ext_vector_type(8))) short;
using s16x4  = __attribute__((ext_vector_type(4))) short;
using f32x4  = __attribute__((ext_vector_type(4))) float;
using f32x16 = __attribute__((ext_vector_type(16))) float;
using u32x2  = __attribute__((ext_vector_type(2))) unsigned;
using u32x4  = __attribute__((ext_vector_type(4))) unsigned;
typedef __bf16 bf16_2 __attribute__((ext_vector_type(2)));
typedef float float_2 __attribute__((ext_vector_type(2)));
#define DI __device__ __forceinline__

constexpr int D = 1024, NB = 8, SEQ = 2048, DEPTH = 4, DB = 128, DS = 8;
constexpr int NTOK_P = NB * SEQ;
constexpr int NTOK = NTOK_P + DB * DS;
constexpr int INW = 2304;
constexpr int NROWS_C = NB + DB;
constexpr int PAST = 8192;
constexpr int TCH = 16;
constexpr int NCH_P = NTOK_P / TCH;
constexpr size_t O_KP = 17825792, O_VP = 18350080, O_SRP = 18874368, O_SIP = 18939904,
                 O_KS = 19005440, O_VS = 27394048, O_SRS = 35782656, O_SIS = 36831232;

struct Params {
  const float *x_prompt, *x_sample, *cache_k, *cache_v, *st_re, *st_im, *c_prompt, *c_sample,
      *norm_g, *w_ada, *b_ada, *w_in, *sinks, *a_re, *a_im, *log_dt, *b_re, *b_im, *c_re, *c_im,
      *ssm_d, *w_glu, *b_glu, *w_out, *final_g;
  float* out;
  char* ws;
  int phase_lo, phase_hi;
};
constexpr size_t al256(size_t x) { return (x + 255) & ~(size_t)255; }
constexpr int LDA = 1088;
constexpr int LDH = 576;
constexpr int LDV = 2112;
constexpr int LDB1 = 320;
constexpr int LDB2 = 448;
constexpr size_t W_WT_IN = 0;
constexpr size_t W_WT_GLU = W_WT_IN + al256((size_t)4 * 2304 * LDA * 2);
constexpr size_t W_WT_OUT = W_WT_GLU + al256((size_t)4 * 512 * LDH * 2);
constexpr size_t W_SC = W_WT_OUT + al256((size_t)4 * 1024 * LDA * 2);
constexpr size_t W_MOD = W_SC + al256((size_t)256 * 1024 * 2);
constexpr size_t W_MIX = W_MOD + al256((size_t)4 * NROWS_C * 3072 * 4);
constexpr size_t W_HN = W_MIX;
constexpr size_t W_WT_ADA = W_MIX;
constexpr size_t W_Q = W_MIX + al256((size_t)NTOK * LDA * 2);
constexpr size_t W_YG = W_Q + al256((size_t)NTOK * LDH * 2);
constexpr size_t W_K = W_YG + al256((size_t)NTOK * LDH * 2);
constexpr size_t W_VT = W_K + al256((size_t)NTOK * 128 * 2);
constexpr size_t W_ZA = W_VT + al256(((size_t)NB * 128 * LDV + (size_t)DB * 128 * 8) * 2);
constexpr size_t W_U = W_ZA + al256((size_t)NTOK * LDH * 2);
constexpr size_t W_ZS = W_U + al256((size_t)NTOK * LDH * 2);
constexpr size_t W_BT1 = W_ZS + al256((size_t)NTOK * LDH * 2);
constexpr size_t W_BT2 = W_BT1 + al256((size_t)128 * 128 * LDB1 * 2);
constexpr size_t W_APOW = W_BT2 + al256((size_t)128 * 256 * LDB2 * 2);
constexpr size_t W_CARRY_P = W_APOW + al256((size_t)128 * 256 * 4);
constexpr size_t W_CARRY_S = W_CARRY_P + al256((size_t)NCH_P * 32 * 128 * 2);
constexpr size_t W_ROPE = W_CARRY_S + al256((size_t)DB * 32 * 128 * 2);
constexpr size_t W_BAR = W_ROPE + al256((size_t)2 * 2056 * 8 * 4);
constexpr size_t W_QUEUE = W_BAR + (size_t)3456 * 4;
constexpr size_t W_TOTAL = W_BAR + al256((size_t)(3456 + 5 * 64) * 4);


DI int TID() { int t = threadIdx.x; asm volatile("" : "+v"(t)); return t; }
DI int BID() { int b = blockIdx.x; asm volatile("" : "+s"(b)); return b; }
DI char* WS(const Params& p) { size_t z = 0; asm volatile("" : "+s"(z)); return p.ws + z; }
DI float* OUTP(const Params& p) { size_t z = 0; asm volatile("" : "+s"(z)); return p.out + z; }

DI unsigned pack2(float a, float b) {
  float_2 f = {a, b};
  bf16_2 r = __builtin_convertvector(f, bf16_2);
  return __builtin_bit_cast(unsigned, r);
}
DI u16 f2bf(float a) { return (u16)(pack2(a, 0.f) & 0xffffu); }
DI float bf2f(u16 v) { return __uint_as_float(((unsigned)v) << 16); }
DI float silu_f(float x) { return x / (1.f + __expf(-x)); }
DI float sigmoid_f(float x) { return 1.f / (1.f + __expf(-x)); }
DI float gelu_tanh(float x) {
  float u = 0.7978845608028654f * (x + 0.044715f * x * x * x);
  return x / (1.f + __expf(-2.f * u));
}
DI const float* xrow_in(const Params& p, int m) {
  return m < NTOK_P ? p.x_prompt + (size_t)m * D : p.x_sample + (size_t)(m - NTOK_P) * D;
}
DI int brow_of(int m) { return m < NTOK_P ? (m >> 11) : NB + ((m - NTOK_P) >> 3); }
template <int MI, class AL, class EP>
DI void gemm_tile(u16* sm, int m0, int n0, int K, AL al, const u16* __restrict__ Bt, int ldb,
                  int bskip_at, int bskip, EP ep) {
  constexpr int BM = 32 * MI;
  u16* As = sm;
  u16* Bs = sm + 2 * BM * 72;
  const int tid = TID(), lane = tid & 63, wid = tid >> 6;
  const int wr = wid >> 1, wc = wid & 1, fr = lane & 15, fq = lane >> 4;
  const int lrow = tid >> 3, lk = (tid & 7) * 8;
  f32x4 acc[MI][4];
#pragma unroll
  for (int m = 0; m < MI; ++m)
#pragma unroll
    for (int n = 0; n < 4; ++n) acc[m][n] = f32x4{0.f, 0.f, 0.f, 0.f};
  bf16x8 pa0[MI], pb0[4], pa1[MI], pb1[4];
  const int nk = K >> 6;
  auto gload = [&](bf16x8* pa, bf16x8* pb, int kt) {
    int k = kt * 64 + lk;
    int kb = k + (k >= bskip_at ? bskip : 0);
#pragma unroll
    for (int i = 0; i < MI; ++i) pa[i] = al(m0 + lrow + 32 * i, k);
#pragma unroll
    for (int i = 0; i < 4; ++i) pb[i] = *(const bf16x8*)(Bt + (size_t)(n0 + lrow + 32 * i) * ldb + kb);
  };
  auto lstore = [&](const bf16x8* pa, const bf16x8* pb, int buf) {
#pragma unroll
    for (int i = 0; i < MI; ++i) *(bf16x8*)(As + buf * BM * 72 + (lrow + 32 * i) * 72 + lk) = pa[i];
#pragma unroll
    for (int i = 0; i < 4; ++i) *(bf16x8*)(Bs + buf * 9216 + (lrow + 32 * i) * 72 + lk) = pb[i];
  };
  auto compute = [&](int cur) {
    const u16* Ac = As + cur * BM * 72 + (wr * MI * 16 + fr) * 72 + fq * 8;
    const u16* Bc = Bs + cur * 9216 + (wc * 64 + fr) * 72 + fq * 8;
    bf16x8 af[2][MI], bv[2][4];
#pragma unroll
    for (int kk = 0; kk < 2; ++kk) {
#pragma unroll
      for (int n = 0; n < 4; ++n) bv[kk][n] = *(const bf16x8*)(Bc + n * 16 * 72 + kk * 32);
#pragma unroll
      for (int m = 0; m < MI; ++m) af[kk][m] = *(const bf16x8*)(Ac + m * 16 * 72 + kk * 32);
    }
    __builtin_amdgcn_sched_barrier(0);
#pragma unroll
    for (int kk = 0; kk < 2; ++kk)
#pragma unroll
      for (int m = 0; m < MI; ++m)
#pragma unroll
        for (int n = 0; n < 4; ++n)
          acc[m][n] = __builtin_amdgcn_mfma_f32_16x16x32_bf16(af[kk][m], bv[kk][n], acc[m][n], 0, 0, 0);
    __builtin_amdgcn_sched_barrier(0);
  };
  gload(pa0, pb0, 0);
  gload(pa1, pb1, 1);
  lstore(pa0, pb0, 0);
  __syncthreads();
  int kt = 0;
  for (; kt + 2 < nk; kt += 2) {
    gload(pa0, pb0, kt + 2);
    compute(0);
    lstore(pa1, pb1, 1);
    __syncthreads();
    gload(pa1, pb1, kt + 3);
    compute(1);
    lstore(pa0, pb0, 0);
    __syncthreads();
  }
  compute(0);
  lstore(pa1, pb1, 1);
  __syncthreads();
  compute(1);
  __syncthreads();
  float* Cs = (float*)sm;
#pragma unroll
  for (int m = 0; m < MI; ++m)
#pragma unroll
    for (int n = 0; n < 4; ++n)
#pragma unroll
      for (int j = 0; j < 4; ++j)
        Cs[(wr * MI * 16 + m * 16 + fq * 4 + j) * 132 + wc * 64 + n * 16 + fr] = acc[m][n][j];
  __syncthreads();
  ep(Cs);
  __syncthreads();
}
template <int BM, class F>
DI void for_chunks(F f) {
  const int tid = TID();
#pragma unroll 2
  for (int it = 0; it < BM / 16; ++it) {
    int idx = tid + 256 * it;
    f(idx >> 4, (idx & 15) * 8);
  }
}
DI void ld8(const float* s, float* v) {
  float4 a = *(const float4*)s, b = *(const float4*)(s + 4);
  v[0] = a.x; v[1] = a.y; v[2] = a.z; v[3] = a.w; v[4] = b.x; v[5] = b.y; v[6] = b.z; v[7] = b.w;
}
DI void st8(float* d, const float* v) {
  *(float4*)d = float4{v[0], v[1], v[2], v[3]};
  *(float4*)(d + 4) = float4{v[4], v[5], v[6], v[7]};
}
DI void st8bf(u16* d, const float* v) {
  u32x4 o = {pack2(v[0], v[1]), pack2(v[2], v[3]), pack2(v[4], v[5]), pack2(v[6], v[7])};
  *(u32x4*)d = o;
}
DI void ld8bf(const u16* s, float* v) {
  u32x4 o = *(const u32x4*)s;
#pragma unroll
  for (int e = 0; e < 4; ++e) { v[2 * e] = __uint_as_float(o[e] << 16); v[2 * e + 1] = __uint_as_float(o[e] & 0xffff0000u); }
}

DI void transpose_tile(float* tl, const float* __restrict__ src, int ldn, u16* __restrict__ dst, int ldk, int kt, int nt) {
  const int tid = TID();
#pragma unroll
  for (int i = 0; i < 4; ++i) {
    int kk = (tid >> 4) + 16 * i, c4 = (tid & 15) * 4;
    float4 v = *(const float4*)(src + (size_t)(kt * 64 + kk) * ldn + nt * 64 + c4);
    tl[kk * 65 + c4 + 0] = v.x; tl[kk * 65 + c4 + 1] = v.y; tl[kk * 65 + c4 + 2] = v.z; tl[kk * 65 + c4 + 3] = v.w;
  }
  __syncthreads();
  {
    int n = tid >> 2, ks = (tid & 3) * 16;
    u32x4 o0, o1;
#pragma unroll
    for (int e = 0; e < 4; ++e) {
      o0[e] = pack2(tl[(ks + 2 * e) * 65 + n], tl[(ks + 2 * e + 1) * 65 + n]);
      o1[e] = pack2(tl[(ks + 8 + 2 * e) * 65 + n], tl[(ks + 8 + 2 * e + 1) * 65 + n]);
    }
    u16* d = dst + (size_t)(nt * 64 + n) * ldk + kt * 64 + ks;
    *(u32x4*)d = o0;
    *(u32x4*)(d + 8) = o1;
  }
  __syncthreads();
}
DI void ssm_tables(const Params& p, float* sm, int lg, int cq) {
  float* pwr = sm;            float* pwi = pwr + 17 * 64;
  float* bbr = pwi + 17 * 64; float* bbi = bbr + 1024;
  float* cr = bbi + 1024;     float* ci = cr + 1024;
  float* Kt = ci + 1024;
  const int tid = TID();
  const float dt = expf(p.log_dt[lg]);
  const float* are = p.a_re + lg * 64;
  const float* aim = p.a_im + lg * 64;
  for (int idx = tid; idx < 17 * 64; idx += 256) {
    int pp = idx & 63, tau = idx >> 6;
    float mag = expf(are[pp] * dt * (float)tau);
    float sn, cs;
    sincosf(aim[pp] * dt * (float)tau, &sn, &cs);
    pwr[idx] = mag * cs; pwi[idx] = mag * sn;
  }
  {
    int pp = tid >> 2, c0 = (tid & 3) * 4;
    float ar = are[pp], ai = aim[pp];
    float x = ar * dt, y = ai * dt;
    float sn, cs, sh, chh;
    sincosf(y, &sn, &cs);
    sincosf(0.5f * y, &sh, &chh);
    float em1 = expm1f(x);
    float nr = em1 * cs - 2.f * sh * sh;
    float ni = (em1 + 1.f) * sn;
    float den = ar * ar + ai * ai;
    float cre = (nr * ar + ni * ai) / den;
    float cim = (ni * ar - nr * ai) / den;
#pragma unroll
    for (int e = 0; e < 4; ++e) {
      float br = p.b_re[(size_t)lg * 1024 + pp * 16 + c0 + e];
      float bi = p.b_im[(size_t)lg * 1024 + pp * 16 + c0 + e];
      bbr[pp * 16 + c0 + e] = cre * br - cim * bi;
      bbi[pp * 16 + c0 + e] = cre * bi + cim * br;
    }
  }
  for (int idx = tid; idx < 1024; idx += 256) {
    cr[idx] = p.c_re[(size_t)lg * 1024 + idx];
    ci[idx] = p.c_im[(size_t)lg * 1024 + idx];
  }
  __syncthreads();
#pragma unroll 1
  for (int e = tid; e < 1024; e += 256) {
    int tau = e >> 6, cl = (e >> 4) & 3, c2 = e & 15, c = cq * 4 + cl;
    float s = 0.f;
#pragma unroll 8
    for (int pp = 0; pp < 64; ++pp) {
      float wr_ = pwr[tau * 64 + pp], wi_ = pwi[tau * 64 + pp];
      float br = bbr[pp * 16 + c2], bi = bbi[pp * 16 + c2];
      float zr = wr_ * br - wi_ * bi, zi = wr_ * bi + wi_ * br;
      s += cr[c * 64 + pp] * zr - ci[c * 64 + pp] * zi;
    }
    if (tau == 0 && c == c2) s += p.ssm_d[lg * 16 + c];
    Kt[e] = s;
  }
  __syncthreads();
  u16* bt2 = ((u16*)(WS(p) + W_BT2)) + (size_t)lg * 256 * LDB2;
#pragma unroll 1
  for (int r = 0; r < 64; ++r) {
    int t = r >> 2, cl = r & 3, c = cq * 4 + cl, n = t * 16 + c;
    {
      int k = tid, s = k >> 4, c2 = k & 15;
      float v = (s <= t) ? Kt[((t - s) << 6) + (cl << 4) + c2] : 0.f;
      bt2[n * LDB2 + k] = f2bf(v);
    }
    if (tid < 128) {
      int pp = tid & 63;
      float wr_ = pwr[(t + 1) * 64 + pp], wi_ = pwi[(t + 1) * 64 + pp];
      float crr = cr[c * 64 + pp], cii = ci[c * 64 + pp];
      float v = (tid < 64) ? (crr * wr_ - cii * wi_) : -(crr * wi_ + cii * wr_);
      bt2[n * LDB2 + 256 + tid] = f2bf(v);
    }
  }
  u16* bt1 = ((u16*)(WS(p) + W_BT1)) + (size_t)lg * 128 * LDB1;
  {
    int k = tid, s = k >> 4, c = k & 15;
#pragma unroll 4
    for (int r = 0; r < 32; ++r) {
      int n = cq * 32 + r, pp = n & 63;
      float wr_ = pwr[(15 - s) * 64 + pp], wi_ = pwi[(15 - s) * 64 + pp];
      float br = bbr[pp * 16 + c], bi = bbi[pp * 16 + c];
      float v = (n < 64) ? (wr_ * br - wi_ * bi) : (wr_ * bi + wi_ * br);
      bt1[n * LDB1 + k] = f2bf(v);
    }
  }
  if (cq == 0 && tid < 64) {
    float* ap = ((float*)(WS(p) + W_APOW)) + (size_t)lg * 256;
    ap[tid] = pwr[16 * 64 + tid]; ap[64 + tid] = pwi[16 * 64 + tid];
    ap[128 + tid] = pwr[8 * 64 + tid]; ap[192 + tid] = pwi[8 * 64 + tid];
  }
  __syncthreads();
}

DI void phase_prep(const Params& p, char* smem, int* q_slot) {
  const int tid = TID();
  constexpr int N_TAB = 512, N_ROPE = 8, N_TR = 6656 / 4, N_CP = 1024, N_SC = 16;
  constexpr int total = N_TAB + N_ROPE + N_TR + N_CP + N_SC;
  unsigned* ctr = (unsigned*)(WS(p) + W_QUEUE) + 4 * 64;
  for (;;) {
    if (threadIdx.x == 0) *q_slot = (int)atomicAdd(ctr, 1u);
    __syncthreads();
    const int it = __builtin_amdgcn_readfirstlane(*q_slot);
    __syncthreads();
    if (it >= total) break;
    int i = it;
    if (i < N_TAB) { ssm_tables(p, (float*)smem, i >> 2, i & 3); continue; }
    i -= N_TAB;
    if (i < N_ROPE) {
      for (int e = i * 2056 + tid; e < (i + 1) * 2056; e += 256) {
        int pi = e >> 3, j = e & 7;
        float pos = (float)(pi < 2048 ? pi : PAST + (pi - 2048));
        float inv = powf(500000.0f, -(float)j / 8.0f);
        float sn, cs;
        sincosf(pos * inv, &sn, &cs);
        ((float*)(WS(p) + W_ROPE))[e] = cs; ((float*)(WS(p) + W_ROPE))[2056 * 8 + e] = sn;
      }
      continue;
    }
    i -= N_ROPE;
    if (i < N_TR) {
      float* tl = (float*)smem;
      const int i4 = i * 4;
#pragma unroll 1
      for (int q4 = 0; q4 < 4; ++q4) {
      const int i = i4 + q4;
      if (i < 3072) { int l = i / 768, rem = i % 768; transpose_tile(tl, p.w_ada + (size_t)l * 1024 * 3072, 3072, ((u16*)(WS(p) + W_WT_ADA)) + (size_t)l * 3072 * LDA, LDA, rem / 48, rem % 48); }
      else if (i < 5376) { int j = i - 3072; int l = j / 576, rem = j % 576; transpose_tile(tl, p.w_in + (size_t)l * 1024 * 2304, 2304, ((u16*)(WS(p) + W_WT_IN)) + (size_t)l * 2304 * LDA, LDA, rem / 36, rem % 36); }
      else if (i < 5632) { int j = i - 5376; int l = j / 64, rem = j % 64; transpose_tile(tl, p.w_glu + (size_t)l * 512 * 512, 512, ((u16*)(WS(p) + W_WT_GLU)) + (size_t)l * 512 * LDH, LDH, rem / 8, rem % 8); }
      else { int j = i - 5632; int l = j / 256, rem = j % 256; transpose_tile(tl, p.w_out + (size_t)l * 1024 * 1024, 1024, ((u16*)(WS(p) + W_WT_OUT)) + (size_t)l * 1024 * LDA, LDA, rem / 16, rem % 16); }
      }
      continue;
    }
    i -= N_TR;
    if (i < N_CP) {
      int which = i >> 9, lb = i & 511;
      const float4* src = (const float4*)((which ? p.cache_v : p.cache_k) + (size_t)lb * 16384 + 8 * 128);
      float4* dst = (float4*)(OUTP(p) + (which ? O_VS : O_KS) + (size_t)lb * 16384);
      for (int e = tid; e < 3840; e += 256) dst[e] = src[e];
      continue;
    }
    i -= N_CP;
    if (i < N_SC) {
      for (int e = tid; e < 16 * 1024; e += 256) {
        int r = i * 16 + (e >> 10), c = e & 1023;
        float v = 0.f;
        if (r < NB) v = silu_f(p.c_prompt[r * D + c]);
        else if (r < NROWS_C) v = silu_f(p.c_sample[(r - NB) * D + c]);
        ((u16*)(WS(p) + W_SC))[r * D + c] = f2bf(v);
      }
    }
  }
}
DI void phase_mod(const Params& p, char* smem) {
  constexpr int NT = 12288 / 128;
  for (int t = BID(); t < 2 * NT; t += gridDim.x) {
    int mt = t / NT, nt = t % NT;
    const int m0 = mt * 128, n0 = nt * 128;
    const u16* A = ((u16*)(WS(p) + W_SC));
    auto al = [&](int row, int k) { return *(const bf16x8*)(A + (size_t)row * D + k); };
    auto ep = [&](const float* Cs) {
      const int l = n0 / 3072, cb = n0 - l * 3072;
      float* md = ((float*)(WS(p) + W_MOD));
      for_chunks<128>([&](int row, int c8) {
        int r = m0 + row;
        if (r < NROWS_C) {
          float v[8], b[8];
          ld8(Cs + row * 132 + c8, v);
          ld8(p.b_ada + l * 3072 + cb + c8, b);
#pragma unroll
          for (int e = 0; e < 8; ++e) v[e] += b[e];
          st8(md + ((size_t)l * NROWS_C + r) * 3072 + cb + c8, v);
        }
      });
    };
    gemm_tile<4>((u16*)smem, m0, n0, 1024, al, ((u16*)(WS(p) + W_WT_ADA)), LDA, 1 << 30, 0, ep);
  }
}

DI void phase_norm(const Params& p, int l) {
  const int lane = TID() & 63, wid = TID() >> 6;
  const float* g = p.norm_g + l * D;
  for (int m = BID() * 4 + wid; m < NTOK; m += gridDim.x * 4) {
    const float* xr = (l == 0) ? xrow_in(p, m) : OUTP(p) + (size_t)m * D;
    const float* md = ((float*)(WS(p) + W_MOD)) + ((size_t)l * NROWS_C + brow_of(m)) * 3072;
    float4 v[4];
    float ss = 0.f;
#pragma unroll
    for (int i = 0; i < 4; ++i) {
      v[i] = *(const float4*)(xr + lane * 4 + 256 * i);
      ss += v[i].x * v[i].x + v[i].y * v[i].y + v[i].z * v[i].z + v[i].w * v[i].w;
    }
#pragma unroll
    for (int o = 32; o > 0; o >>= 1) ss += __shfl_xor(ss, o);
    float rstd = rsqrtf(ss * (1.f / D) + 1e-6f);
#pragma unroll
    for (int i = 0; i < 4; ++i) {
      int c = lane * 4 + 256 * i;
      float4 gg = *(const float4*)(g + c);
      float4 sh = *(const float4*)(md + c);
      float4 sc = *(const float4*)(md + 1024 + c);
      float a0 = v[i].x * rstd * gg.x * (1.f + sc.x) + sh.x;
      float a1 = v[i].y * rstd * gg.y * (1.f + sc.y) + sh.y;
      float a2 = v[i].z * rstd * gg.z * (1.f + sc.z) + sh.z;
      float a3 = v[i].w * rstd * gg.w * (1.f + sc.w) + sh.w;
      u32x2 o = {pack2(a0, a1), pack2(a2, a3)};
      *(u32x2*)(((u16*)(WS(p) + W_HN)) + (size_t)m * LDA + c) = o;
    }
  }
}
DI void phase_inproj(const Params& p, char* smem, int l, int vx, int vj) {
  constexpr int NT = INW / 128;
  constexpr int MT = NTOK / 128;
  const u16* Bt = ((u16*)(WS(p) + W_WT_IN)) + (size_t)l * INW * LDA;
  const int xcd = vx, nxb = gridDim.x >> 3;
  constexpr int PW = 9, MX = MT / 8;
  for (int i = vj; i < MX * NT; i += nxb) {
    int panel = i / (MX * PW), r = i - panel * (MX * PW);
    int mt = xcd * MX + r / PW, nt = panel * PW + r % PW;
    const int m0 = mt * 128, n0 = nt * 128;
    const u16* A = ((u16*)(WS(p) + W_HN));
    auto al = [&](int row, int k) { return *(const bf16x8*)(A + (size_t)row * LDA + k); };
    auto ep = [&](const float* Cs) {
      float* out = OUTP(p);
      if (nt < 5) {
        const float* rope = ((float*)(WS(p) + W_ROPE));
        u16* qd = ((u16*)(WS(p) + W_Q));
        u16* kd = ((u16*)(WS(p) + W_K));
        for_chunks<128>([&](int row, int c8) {
          const int m = m0 + row;
          const bool is_p = m < NTOK_P;
          int b, pos, ridx;
          if (is_p) { b = m >> 11; pos = m & 2047; ridx = pos; }
          else { int rr = m - NTOK_P; b = rr >> 3; pos = rr & 7; ridx = 2048 + pos; }
          float v[8];
          const float* c = Cs + row * 132 + c8;
          ld8(c, v);
          const int dd = c8 & 63;
          if (dd < 16) {
            float cs[8], sn[8], o[8];
            ld8(rope + ridx * 8, cs);
            ld8(rope + 2056 * 8 + ridx * 8, sn);
            if (dd == 0) { ld8(c + 8, o);
#pragma unroll
              for (int e = 0; e < 8; ++e) v[e] = v[e] * cs[e] - o[e] * sn[e];
            } else { ld8(c - 8, o);
#pragma unroll
              for (int e = 0; e < 8; ++e) v[e] = v[e] * cs[e] + o[e] * sn[e];
            }
          }
          if (nt < 4) st8bf(qd + (size_t)m * LDH + n0 + c8, v);
          else {
            st8bf(kd + (size_t)m * 128 + c8, v);
            if (is_p) { if (pos >= SEQ - 128) st8(out + O_KP + ((size_t)(l * NB + b) * 128 + (pos - (SEQ - 128))) * 128 + c8, v); }
            else st8(out + O_KS + ((size_t)(l * DB + b) * 128 + 120 + pos) * 128 + c8, v);
          }
        });
      } else if (nt == 5) {
        u16* vT = ((u16*)(WS(p) + W_VT));
        const int tid = TID();
#pragma unroll 2
        for (int it = 0; it < 8; ++it) {
          int idx = tid + 256 * it, col = idx & 127, rg = idx >> 7;
          const int m = m0 + rg * 8;
          float v[8];
#pragma unroll
          for (int e = 0; e < 8; ++e) v[e] = Cs[(rg * 8 + e) * 132 + col];
          if (m < NTOK_P) {
            int b = m >> 11, pos0 = m & 2047;
            st8bf(vT + ((size_t)(b * 128 + col)) * LDV + pos0, v);
            if (pos0 >= SEQ - 128) {
#pragma unroll
              for (int e = 0; e < 8; ++e) out[O_VP + ((size_t)(l * NB + b) * 128 + (pos0 + e - (SEQ - 128))) * 128 + col] = v[e];
            }
          } else {
            int b = (m - NTOK_P) >> 3;
            st8bf(vT + (size_t)NB * 128 * LDV + ((size_t)(b * 128 + col)) * 8, v);
#pragma unroll
            for (int e = 0; e < 8; ++e) out[O_VS + ((size_t)(l * DB + b) * 128 + 120 + e) * 128 + col] = v[e];
          }
        }
      } else {
        u16* dst; int cb;
        if (nt < 10) { dst = ((u16*)(WS(p) + W_ZA)); cb = n0 - 768; }
        else if (nt < 14) { dst = ((u16*)(WS(p) + W_U)); cb = n0 - 1280; }
        else { dst = ((u16*)(WS(p) + W_ZS)); cb = n0 - 1792; }
        const bool is_u = (nt >= 10) && (nt < 14);
        for_chunks<128>([&](int row, int c8) {
          float v[8];
          ld8(Cs + row * 132 + c8, v);
          const int c = cb + c8;
          if (is_u) st8bf(dst + ((size_t)(c >> 4) * NTOK + (m0 + row)) * 16 + (c & 15), v);
          else st8bf(dst + (size_t)(m0 + row) * LDH + c, v);
        });
      }
    };
    gemm_tile<4>((u16*)smem, m0, n0, 1024, al, Bt, LDA, 1 << 30, 0, ep);
  }
}

DI int crow(int i, int h) { return (i & 3) + 8 * (i >> 2) + 4 * h; }

template <bool SAMPLE>
DI void attn_task(const Params& p, int l, const u16* Ks, const u16* Vt, int VS, int koff, int kp0,
                  const u16* qptr, int qp, float sink, int tok_base, int head_base) {
  const int lane = TID() & 63, r = lane & 31, h = lane >> 5;
  bf16x8 qf[4];
#pragma unroll
  for (int s = 0; s < 4; ++s) qf[s] = *(const bf16x8*)(qptr + 16 * s + 8 * h);
  f32x16 sc[5];
#pragma unroll
  for (int t = 0; t < 5; ++t) {
    f32x16 acc;
#pragma unroll
    for (int i = 0; i < 16; ++i) acc[i] = 0.f;
#pragma unroll
    for (int s = 0; s < 4; ++s) {
      bf16x8 a = *(const bf16x8*)(Ks + (koff + t * 32 + r) * 72 + 16 * s + 8 * h);
      acc = __builtin_amdgcn_mfma_f32_32x32x16_bf16(a, qf[s], acc, 0, 0, 0);
    }
    sc[t] = acc;
  }
  float m = sink;
#pragma unroll
  for (int t = 0; t < 5; ++t)
#pragma unroll
    for (int i = 0; i < 16; ++i) {
      int kp = kp0 + koff + t * 32 + crow(i, h);
      int df = qp - kp;
      bool valid = (df >= 0) && (df <= 128) && (kp >= 0);
      float s = valid ? sc[t][i] * 0.125f : -1e30f;
      sc[t][i] = s;
      m = fmaxf(m, s);
    }
  m = fmaxf(m, __shfl_xor(m, 32));
  float lsum = 0.f;
#pragma unroll
  for (int t = 0; t < 5; ++t)
#pragma unroll
    for (int i = 0; i < 16; ++i) {
      float e = __expf(sc[t][i] - m);
      sc[t][i] = e;
      lsum += e;
    }
  lsum += __shfl_xor(lsum, 32);
  float inv = 1.f / (lsum + __expf(sink - m));
  f32x16 o[2];
#pragma unroll
  for (int i = 0; i < 16; ++i) { o[0][i] = 0.f; o[1][i] = 0.f; }
#pragma unroll
  for (int t = 0; t < 5; ++t)
#pragma unroll
    for (int s = 0; s < 2; ++s) {
      u32x4 pk;
#pragma unroll
      for (int e = 0; e < 4; ++e) pk[e] = pack2(sc[t][8 * s + 2 * e], sc[t][8 * s + 2 * e + 1]);
      bf16x8 pa = __builtin_bit_cast(bf16x8, pk);
      int kb = koff + t * 32 + 16 * s + 4 * h;
#pragma unroll
      for (int dt = 0; dt < 2; ++dt) {
        const u16* vp = Vt + (dt * 32 + r) * VS + kb;
        s16x4 lo = *(const s16x4*)vp;
        s16x4 hi = *(const s16x4*)(vp + 8);
        bf16x8 vb = __builtin_shufflevector(lo, hi, 0, 1, 2, 3, 4, 5, 6, 7);
        o[dt] = __builtin_amdgcn_mfma_f32_32x32x16_bf16(pa, vb, o[dt], 0, 0, 0);
      }
    }
  u16 zz[32];
#pragma unroll
  for (int i = 0; i < 16; ++i) {
    int row = crow(i, h);
    int tok, head;
    if (SAMPLE) { tok = tok_base + (row & 7); head = head_base + (row >> 3); }
    else { tok = tok_base + row; head = head_base; }
#pragma unroll
    for (int dt = 0; dt < 2; ++dt) zz[i * 2 + dt] = ((const u16*)(WS(p) + W_ZA))[(size_t)tok * LDH + head * 64 + dt * 32 + r];
  }
#pragma unroll
  for (int i = 0; i < 16; ++i) {
    int row = crow(i, h);
    float iq = __shfl(inv, row);
    int tok, head;
    if (SAMPLE) { tok = tok_base + (row & 7); head = head_base + (row >> 3); }
    else { tok = tok_base + row; head = head_base; }
#pragma unroll
    for (int dt = 0; dt < 2; ++dt) {
      int c = head * 64 + dt * 32 + r;
      float z = bf2f(zz[i * 2 + dt]);
      ((u16*)(WS(p) + W_MIX))[(size_t)tok * LDA + c] = f2bf(o[dt][i] * iq * silu_f(z));
    }
  }
}

DI void attn_prompt_item(const Params& p, char* smem, int l, int it) {
  const int tid = TID(), wid = tid >> 6, lane = tid & 63;
  const int b = it >> 6, h = (it >> 5) & 1, n = (it >> 1) & 15, half = it & 1;
  const int qb = n * 128 + half * 64, kstart = qb - 128;
  u16* Ks = (u16*)smem;
  u16* Vt = Ks + 192 * 72;
  for (int idx = tid; idx < 192 * 8; idx += 256) {
    int key = idx >> 3, ch = idx & 7, pos = kstart + key;
    bf16x8 v = {0, 0, 0, 0, 0, 0, 0, 0};
    if (pos >= 0) v = *(const bf16x8*)(((u16*)(WS(p) + W_K)) + ((size_t)(b * SEQ + pos)) * 128 + h * 64 + ch * 8);
    *(bf16x8*)(Ks + key * 72 + ch * 8) = v;
  }
  for (int idx = tid; idx < 64 * 24; idx += 256) {
    int d = idx / 24, ch = idx - d * 24, pos0 = kstart + ch * 8;
    s16x4 lo = {0, 0, 0, 0}, hi = {0, 0, 0, 0};
    if (pos0 >= 0) {
      const u16* src = ((u16*)(WS(p) + W_VT)) + ((size_t)((b * 2 + h) * 64 + d)) * LDV + pos0;
      lo = *(const s16x4*)src; hi = *(const s16x4*)(src + 4);
    }
    *(s16x4*)(Vt + d * 196 + ch * 8) = lo;
    *(s16x4*)(Vt + d * 196 + ch * 8 + 4) = hi;
  }
  __syncthreads();
  const int head = h * 4 + wid;
  const float sink = p.sinks[l * 8 + head];
#pragma unroll 1
  for (int r = 0; r < 2; ++r) {
    int q0 = qb + r * 32;
    const u16* qptr = ((u16*)(WS(p) + W_Q)) + ((size_t)(b * SEQ + q0 + (lane & 31))) * LDH + head * 64;
    attn_task<false>(p, l, Ks, Vt, 196, r * 32, kstart, qptr, q0 + (lane & 31), sink, b * SEQ + q0, head);
  }
  __syncthreads();
}

DI void attn_sample_item(const Params& p, char* smem, int l, int it) {
  const int tid = TID(), wid = tid >> 6, lane = tid & 63;
  const int b = it >> 1, h = it & 1;
  u16* Ks = (u16*)smem;
  u16* Vt = Ks + 160 * 72;
  const float* ck = p.cache_k + ((size_t)(l * DB + b)) * 16384 + h * 64;
  const float* cv = p.cache_v + ((size_t)(l * DB + b)) * 16384 + h * 64;
  for (int idx = tid; idx < 160 * 16; idx += 256) {
    int key = idx >> 4, c4 = (idx & 15) * 4;
    u32x2 o = {0u, 0u};
    if (key < 128) {
      float4 v = *(const float4*)(ck + (size_t)key * 128 + c4);
      o[0] = pack2(v.x, v.y); o[1] = pack2(v.z, v.w);
    } else if (key < 136) {
      o = *(const u32x2*)(((u16*)(WS(p) + W_K)) + ((size_t)(NTOK_P + b * 8 + key - 128)) * 128 + h * 64 + c4);
    }
    *(u32x2*)(Ks + key * 72 + c4) = o;
  }
  for (int idx = tid; idx < 128 * 16; idx += 256) {
    int key = idx >> 4, c4 = (idx & 15) * 4;
    float4 v = *(const float4*)(cv + (size_t)key * 128 + c4);
    Vt[(c4 + 0) * 164 + key] = f2bf(v.x);
    Vt[(c4 + 1) * 164 + key] = f2bf(v.y);
    Vt[(c4 + 2) * 164 + key] = f2bf(v.z);
    Vt[(c4 + 3) * 164 + key] = f2bf(v.w);
  }
  if (tid < 64) {
    int d = tid;
    const u16* src = ((u16*)(WS(p) + W_VT)) + (size_t)NB * 128 * LDV + ((size_t)((b * 2 + h) * 64 + d)) * 8;
    s16x4 lo = *(const s16x4*)src, hi = *(const s16x4*)(src + 4);
    s16x4 z = {0, 0, 0, 0};
    u16* dst = Vt + d * 164 + 128;
    *(s16x4*)dst = lo; *(s16x4*)(dst + 4) = hi;
#pragma unroll
    for (int e = 2; e < 8; ++e) *(s16x4*)(dst + 4 * e) = z;
  }
  __syncthreads();
  if (wid == 0) {
    int r = lane & 31, g = r >> 3, t = r & 7;
    const u16* qptr = ((u16*)(WS(p) + W_Q)) + ((size_t)(NTOK_P + b * 8 + t)) * LDH + (h * 4 + g) * 64;
    float sink = p.sinks[l * 8 + h * 4 + g];
    attn_task<true>(p, l, Ks, Vt, 164, 0, PAST - 128, qptr, PAST + t, sink, NTOK_P + b * 8, h * 4);
  }
  __syncthreads();
}
DI void ssm_g1_tile(const Params& p, char* smem, int l, int it) {
  const bool smp = it >= 256;
  const int g = smp ? it - 256 : (it & 31);
  const int mt = smp ? 0 : (it >> 5);
  const u16* U = ((u16*)(WS(p) + W_U));
  auto al = [&](int row, int k) {
    int tok = smp ? (NTOK_P + row * 8 + (k >> 4)) : (row * 16 + (k >> 4));
    return *(const bf16x8*)(U + ((size_t)g * NTOK + tok) * 16 + (k & 15));
  };
  const float* ap = ((float*)(WS(p) + W_APOW)) + (size_t)(l * 32 + g) * 256;
  auto ep = [&](const float* Csc) {
    float* Cs = const_cast<float*>(Csc);
    float* out = OUTP(p);
    const int tid = TID();
    if (smp) {
      u16* cr = ((u16*)(WS(p) + W_CARRY_S));
      for_chunks<128>([&](int row, int c8) {
        const int b = row, pp = c8 & 63;
        const bool im = c8 >= 64;
        float s[8], hr[8], hi[8], ar[8], ai[8], o[8];
        ld8(Cs + row * 132 + c8, s);
        size_t si = ((size_t)(l * DB + b) * 32 + g) * 64 + pp;
        ld8(p.st_re + si, hr); ld8(p.st_im + si, hi);
        ld8(ap + 128 + pp, ar); ld8(ap + 192 + pp, ai);
#pragma unroll
        for (int e = 0; e < 8; ++e) o[e] = im ? (ar[e] * hi[e] + ai[e] * hr[e] + s[e]) : (ar[e] * hr[e] - ai[e] * hi[e] + s[e]);
        st8(out + (im ? O_SIS : O_SRS) + si, o);
        st8bf(cr + ((size_t)g * DB + b) * 128 + c8, im ? hi : hr);
      });
    } else {
      const int b = mt;
      const int pp = tid & 63, sg = tid >> 6;
      const float ar = ap[pp], ai = ap[64 + pp];
      float hr = 0.f, hi = 0.f;
#pragma unroll 4
      for (int j = sg * 32; j < sg * 32 + 32; ++j) {
        float sr = Cs[j * 132 + pp], si = Cs[j * 132 + 64 + pp];
        float nr = ar * hr - ai * hi + sr, ni = ar * hi + ai * hr + si;
        hr = nr; hi = ni;
      }
      float pr = ar, pi = ai;
#pragma unroll
      for (int q = 0; q < 5; ++q) { float t = pr * pr - pi * pi; pi = 2.f * pr * pi; pr = t; }
      float* Ls = Cs + 128 * 132;
      Ls[sg * 128 + pp] = hr; Ls[sg * 128 + 64 + pp] = hi;
      __syncthreads();
      float cr_ = 0.f, ci_ = 0.f;
      for (int s2 = 0; s2 < sg; ++s2) {
        float lr = Ls[s2 * 128 + pp], li = Ls[s2 * 128 + 64 + pp];
        float nr = pr * cr_ - pi * ci_ + lr, ni = pr * ci_ + pi * cr_ + li;
        cr_ = nr; ci_ = ni;
      }
      hr = cr_; hi = ci_;
#pragma unroll 4
      for (int j = sg * 32; j < sg * 32 + 32; ++j) {
        float sr = Cs[j * 132 + pp], si = Cs[j * 132 + 64 + pp];
        Cs[j * 132 + pp] = hr; Cs[j * 132 + 64 + pp] = hi;
        float nr = ar * hr - ai * hi + sr, ni = ar * hi + ai * hr + si;
        hr = nr; hi = ni;
      }
      if (sg == 3) {
        out[O_SRP + ((size_t)(l * NB + b) * 32 + g) * 64 + pp] = hr;
        out[O_SIP + ((size_t)(l * NB + b) * 32 + g) * 64 + pp] = hi;
      }
      __syncthreads();
      u16* cr = ((u16*)(WS(p) + W_CARRY_P));
      for_chunks<128>([&](int row, int c8) {
        float v[8];
        ld8(Cs + row * 132 + c8, v);
        st8bf(cr + ((size_t)g * NCH_P + (b * 128 + row)) * 128 + c8, v);
      });
    }
  };
  const u16* Bt = ((u16*)(WS(p) + W_BT1)) + (size_t)(l * 32 + g) * 128 * LDB1 + (smp ? 128 : 0);
  gemm_tile<4>((u16*)smem, mt * 128, 0, smp ? 128 : 256, al, Bt, LDB1, 1 << 30, 0, ep);
}

DI void ssm_y_tile(const Params& p, char* smem, int l, int it) {
  {
    const bool smp = it >= 512;
    int g, mt, nt;
    if (smp) { g = it - 512; mt = 0; nt = 0; }
    else { g = it & 31; nt = (it >> 5) & 1; mt = it >> 6; }
    const int KU = (smp || nt == 0) ? 128 : 256;
    const int m0 = mt * 128, n0 = nt * 128;
    const u16* U = ((u16*)(WS(p) + W_U));
    const u16* CR = smp ? ((u16*)(WS(p) + W_CARRY_S)) : ((u16*)(WS(p) + W_CARRY_P));
    auto al = [&](int row, int k) {
      if (k < KU) {
        int tok = smp ? (NTOK_P + row * 8 + (k >> 4)) : (row * 16 + (k >> 4));
        return *(const bf16x8*)(U + ((size_t)g * NTOK + tok) * 16 + (k & 15));
      } else {
        return *(const bf16x8*)(CR + ((size_t)g * (smp ? DB : NCH_P) + row) * 128 + (k - KU));
      }
    };
    auto ep = [&](const float* Cs) {
      u16* yg = ((u16*)(WS(p) + W_YG));
      for_chunks<128>([&](int row, int c8) {
        int col = n0 + c8, t = col >> 4, c0 = col & 15;
        int tok = smp ? (NTOK_P + (m0 + row) * 8 + t) : ((m0 + row) * 16 + t);
        float v[8];
        ld8(Cs + row * 132 + c8, v);
#pragma unroll
        for (int e = 0; e < 8; ++e) v[e] = gelu_tanh(v[e]);
        st8bf(yg + (size_t)tok * LDH + g * 16 + c0, v);
      });
    };
    const u16* Bt = ((u16*)(WS(p) + W_BT2)) + (size_t)(l * 32 + g) * 256 * LDB2;
    gemm_tile<4>((u16*)smem, m0, n0, KU + 128, al, Bt, LDB2, KU, 256 - KU, ep);
  }
}

DI void phase_attn(const Params& p, char* smem, int l, int* q_slot) {
  unsigned* ctr = (unsigned*)(WS(p) + W_QUEUE) + l * 64;
  for (;;) {
    if (threadIdx.x == 0) *q_slot = (int)atomicAdd(ctr, 1u);
    __syncthreads();
    const int it = __builtin_amdgcn_readfirstlane(*q_slot);
    __syncthreads();
    if (it >= 1056) break;
    if (it < 256) {
      const int b = it >> 5, g = it & 31;
      ssm_g1_tile(p, smem, l, it);
      __threadfence_block();
      asm volatile("s_waitcnt vmcnt(0)" ::: "memory");
      __syncthreads();
      ssm_y_tile(p, smem, l, b * 64 + g);
      ssm_y_tile(p, smem, l, b * 64 + 32 + g);
    } else if (it < 768) {
      attn_prompt_item(p, smem, l, it - 256);
    } else if (it < 1024) {
      attn_sample_item(p, smem, l, it - 768);
    } else {
      ssm_g1_tile(p, smem, l, 256 + (it - 1024));
      __threadfence_block();
      asm volatile("s_waitcnt vmcnt(0)" ::: "memory");
      __syncthreads();
      ssm_y_tile(p, smem, l, 512 + (it - 1024));
    }
  }
}

DI void phase_glu(const Params& p, char* smem, int l, int vx, int vj) {
  constexpr int MI = 2, BM = 32 * MI;
  constexpr int MT = NTOK / BM, NT = 4;
  const u16* Bt = ((u16*)(WS(p) + W_WT_GLU)) + (size_t)l * 512 * LDH;
  const int xcd = vx, nxb = gridDim.x >> 3;
  constexpr int MX = MT / 8;
  for (int i = vj; i < MX * NT; i += nxb) {
    int mt = xcd * MX + i / NT, nt = i % NT;
    const int m0 = mt * BM, n0 = nt * 128;
    const u16* A = ((u16*)(WS(p) + W_YG));
    auto al = [&](int row, int k) { return *(const bf16x8*)(A + (size_t)row * LDH + k); };
    auto ep = [&](const float* Cs) {
      const u16* yg = ((u16*)(WS(p) + W_YG));
      const u16* zs = ((u16*)(WS(p) + W_ZS));
      u16* mix = ((u16*)(WS(p) + W_MIX));
      for_chunks<BM>([&](int row, int c8) {
        const int m = m0 + row, col = n0 + c8;
        float v[8], y[8], z[8], bg[8];
        ld8(Cs + row * 132 + c8, v);
        ld8bf(yg + (size_t)m * LDH + col, y);
        ld8bf(zs + (size_t)m * LDH + col, z);
        ld8(p.b_glu + l * 512 + col, bg);
#pragma unroll
        for (int e = 0; e < 8; ++e) v[e] = y[e] * sigmoid_f(v[e] + bg[e]) * silu_f(z[e]);
        st8bf(mix + (size_t)m * LDA + 512 + col, v);
      });
    };
    gemm_tile<MI>((u16*)smem, m0, n0, 512, al, Bt, LDH, 1 << 30, 0, ep);
  }
}

template <int MI>
DI void outproj_tile(const Params& p, char* smem, int l, int m0, int n0) {
  constexpr int BM = 32 * MI;
  const u16* Bt = ((u16*)(WS(p) + W_WT_OUT)) + (size_t)l * 1024 * LDA;
  const u16* A = ((u16*)(WS(p) + W_MIX));
  auto al = [&](int row, int k) { return *(const bf16x8*)(A + (size_t)row * LDA + k); };
  auto ep = [&](const float* Cs) {
    float* out = OUTP(p);
    const float* md = ((float*)(WS(p) + W_MOD));
    for_chunks<BM>([&](int row, int c8) {
      const int m = m0 + row, col = n0 + c8;
      float v[8], gt[8], xo[8];
      ld8(Cs + row * 132 + c8, v);
      ld8(md + ((size_t)l * NROWS_C + brow_of(m)) * 3072 + 2048 + col, gt);
      ld8((l == 0) ? xrow_in(p, m) + col : out + (size_t)m * D + col, xo);
#pragma unroll
      for (int e = 0; e < 8; ++e) v[e] = xo[e] + gt[e] * v[e];
      st8(out + (size_t)m * D + col, v);
    });
  };
  gemm_tile<MI>((u16*)smem, m0, n0, 1024, al, Bt, LDA, 1 << 30, 0, ep);
}
DI void phase_outproj(const Params& p, char* smem, int l, int vx, int vj) {
  const int xcd = vx, nxb = gridDim.x >> 3;
  for (int i = vj; i < 16 * 8; i += nxb) outproj_tile<4>(p, smem, l, (xcd * 16 + i / 8) * 128, (i % 8) * 128);
  for (int i = vj; i < 4 * 8; i += nxb) outproj_tile<1>(p, smem, l, NTOK_P + (xcd * 4 + i / 8) * 32, (i % 8) * 128);
}

DI void phase_final(const Params& p) {
  const int lane = TID() & 63, wid = TID() >> 6;
  for (int m = BID() * 4 + wid; m < NTOK; m += gridDim.x * 4) {
    float* xr = OUTP(p) + (size_t)m * D;
    float4 v[4];
    float ss = 0.f;
#pragma unroll
    for (int i = 0; i < 4; ++i) {
      v[i] = *(const float4*)(xr + lane * 4 + 256 * i);
      ss += v[i].x * v[i].x + v[i].y * v[i].y + v[i].z * v[i].z + v[i].w * v[i].w;
    }
#pragma unroll
    for (int o = 32; o > 0; o >>= 1) ss += __shfl_xor(ss, o);
    float rstd = rsqrtf(ss * (1.f / D) + 1e-6f);
#pragma unroll
    for (int i = 0; i < 4; ++i) {
      int c = lane * 4 + 256 * i;
      float4 gg = *(const float4*)(p.final_g + c);
      float4 o = {v[i].x * rstd * gg.x, v[i].y * rstd * gg.y, v[i].z * rstd * gg.z, v[i].w * rstd * gg.w};
      *(float4*)(xr + c) = o;
    }
  }
}

#define XB_TMO      128
#define XB_XCNT(j)  (256  + 64 * (j))
#define XB_XSUB(j)  (1280 + 64 * (j))
#define XB_XGEN(j)  (2304 + 64 * (j))
#define XB_TOP      3328
#define XB_TOPGEN   3392
#define XCD_BAR_WORDS 3456
#define XB_SPIN_CAP (1u << 18)
#define LAS __attribute__((address_space(3)))
DI unsigned xb_ld(unsigned* p)              { return __hip_atomic_load(p, __ATOMIC_RELAXED, __HIP_MEMORY_SCOPE_AGENT); }
DI unsigned xb_add(unsigned* p, unsigned v) { return __hip_atomic_fetch_add(p, v, __ATOMIC_RELAXED, __HIP_MEMORY_SCOPE_AGENT); }
DI unsigned xb_xcc_id() { return (unsigned)__builtin_amdgcn_s_getreg((3 << 11) | 20) & 0xFu; }
#define XB_SPIN(cond, bar) do { unsigned _sp = 0; while (cond) { __builtin_amdgcn_s_sleep(1); \
    if ((++_sp & 255u) == 0u) { if (xb_ld(&(bar)[XB_TMO])) break; if (_sp > XB_SPIN_CAP) { atomicAdd(&(bar)[XB_TMO], 1u); break; } } } } while (0)
struct XcdBarrier { unsigned* bar; unsigned x; volatile LAS unsigned* st; };
DI XcdBarrier xcd_barrier_post(unsigned* bar, volatile LAS unsigned* st) {
  XcdBarrier b; b.bar = bar; b.x = xb_xcc_id(); b.st = st;
  if (threadIdx.x == 0) st[2] = xb_add(&bar[XB_XCNT(b.x)], 1u);
  return b;
}
DI void xcd_barrier_complete(unsigned* bar, unsigned x, unsigned& nloc, unsigned& nx, unsigned& bal) {
  const unsigned G = gridDim.x * gridDim.y * gridDim.z;
  unsigned sum, cnt, mine, sp = 0u, even;
  for (;;) {
    sum = 0u; cnt = 0u; mine = 0u; even = 1u;
#pragma unroll
    for (unsigned j = 0; j < 16; ++j) { const unsigned c = xb_ld(&bar[XB_XCNT(j)]); sum += c; cnt += (c > 0u) ? 1u : 0u; mine = (j == x) ? c : mine;
      if (c != ((j < 8u) ? (G >> 3) : 0u)) even = 0u; }
    if (sum == G) break;
    __builtin_amdgcn_s_sleep(1);
    if ((++sp & 255u) == 0u) { if (xb_ld(&bar[XB_TMO])) break; if (sp > XB_SPIN_CAP) { atomicAdd(&bar[XB_TMO], 1u); break; } }
  }
  nloc = mine > 0u ? mine : 1u; nx = cnt > 0u ? cnt : 1u;
  bal = (sum == G && even) ? 2u : 1u;
}
DI void xcd_barrier(const XcdBarrier& b) {
  asm volatile("s_waitcnt vmcnt(0)" ::: "memory");
  __syncthreads();
  if (threadIdx.x == 0) {
    unsigned* bar = b.bar;
    __builtin_amdgcn_s_waitcnt(0);
    unsigned nloc = b.st[0], nx = b.st[1];
    if (nloc == 0u) { unsigned bal; xcd_barrier_complete(bar, b.x, nloc, nx, bal); b.st[0] = nloc; b.st[1] = nx; b.st[3] = bal; }
    const unsigned old = xb_add(&bar[XB_XSUB(b.x)], 1u);
    const unsigned gen = old / nloc;
    if (old + 1u == (gen + 1u) * nloc) {
      __builtin_amdgcn_fence(__ATOMIC_RELEASE, "agent");
      asm volatile("s_waitcnt vmcnt(0)" ::: "memory");
      const unsigned og = xb_add(&bar[XB_TOP], 1u);
      const unsigned tg = og / nx;
      if (og + 1u == (tg + 1u) * nx) xb_add(&bar[XB_TOPGEN], 1u);
      else XB_SPIN(xb_ld(&bar[XB_TOPGEN]) == tg, bar);
      __builtin_amdgcn_fence(__ATOMIC_ACQUIRE, "agent");
      xb_add(&bar[XB_XGEN(b.x)], 1u);
      asm volatile("s_waitcnt vmcnt(0)" ::: "memory");
    } else {
      XB_SPIN(xb_ld(&bar[XB_XGEN(b.x)]) == gen, bar);
      __builtin_amdgcn_fence(__ATOMIC_ACQUIRE, "agent");
      asm volatile("s_waitcnt vmcnt(0)" ::: "memory");
    }
  }
  __syncthreads();
}
constexpr int N_PHASES = 2 + 5 * DEPTH + 1;

__global__ void __launch_bounds__(256, 2) fwd_kernel(Params p) {
  __shared__ __attribute__((aligned(16))) char smem[73728];
  __shared__ uint4 xb_words;
  __shared__ int q_slot;
  cg::grid_group grid = cg::this_grid();
  if (threadIdx.x == 0) xb_words = make_uint4(0u, 0u, 0u, 0u);
  __syncthreads();
  XcdBarrier xb = xcd_barrier_post((unsigned*)(p.ws + W_BAR), (volatile LAS unsigned*)&xb_words);
  if (p.phase_lo < 0) grid.sync();
  for (int ph = p.phase_lo; ph < p.phase_hi; ++ph) {
    int vx = BID() & 7, vj = BID() >> 3;
    if (USE_XCC_MAP && xb.st[3] == 2u) { vx = (int)xb.x; vj = (int)xb.st[2]; }
    vx = __builtin_amdgcn_readfirstlane(vx); vj = __builtin_amdgcn_readfirstlane(vj);
    if (ph == 0) phase_prep(p, smem, &q_slot);
    else if (ph == 1) { for (int r = 0; r < REP_MOD; ++r) phase_mod(p, smem); }
    else if (ph == N_PHASES - 1) phase_final(p);
    else {
      int l = (ph - 2) / 5, s = (ph - 2) % 5;
      switch (s) {
        case 0: for (int r = 0; r < REP_NORM; ++r) phase_norm(p, l); break;
        case 1: for (int r = 0; r < REP_INPROJ; ++r) phase_inproj(p, smem, l, vx, vj); break;
        case 2: phase_attn(p, smem, l, &q_slot); break;
        case 3: for (int r = 0; r < REP_GLU; ++r) phase_glu(p, smem, l, vx, vj); break;
        default: for (int r = 0; r < (l == 0 ? REP_OUT0 : 1); ++r) phase_outproj(p, smem, l, vx, vj); break;
      }
    }
    if (ph + 1 < p.phase_hi) xcd_barrier(xb);
  }
}

extern "C" void kernel_launch(void* const* d_in, const int* in_sizes, int n_in, void* d_out, int out_size,
                              void* d_ws, size_t ws_size, hipStream_t stream) {
  static int grid_blocks = 0;
  if (!grid_blocks) {
    int dev = 0, cus = 0, per_cu = 0;
    hipGetDevice(&dev);
    hipDeviceGetAttribute(&cus, hipDeviceAttributeMultiprocessorCount, dev);
    hipOccupancyMaxActiveBlocksPerMultiprocessor(&per_cu, fwd_kernel, 256, 0);
    if (per_cu > 2) per_cu = 2;
    if (per_cu < 1) per_cu = 1;
    grid_blocks = cus * per_cu;
  }
  Params p{};
  const float** fp = (const float**)&p;
  for (int i = 0; i < 25; ++i) fp[i] = (const float*)d_in[i];
  p.out = (float*)d_out;
  p.ws = (char*)d_ws;
  if (W_TOTAL > ws_size) fprintf(stderr, "workspace too small: need %zu have %zu\n", (size_t)W_TOTAL, ws_size);
  hipMemsetAsync((char*)d_ws + W_BAR, 0, (size_t)(3456 + 5 * 64) * 4, stream);
  p.phase_lo = 0; p.phase_hi = N_PHASES;
  void* args[] = {&p};
  hipError_t e = hipLaunchCooperativeKernel((void*)fwd_kernel, dim3(grid_blocks), dim3(256), args, 0, stream);
  if (e != hipSuccess) fprintf(stderr, "cooperative launch failed: %s (grid %d)\n", hipGetErrorString(e), grid_blocks);
}
```

```cpp
#include <hip/hip_runtime.h>
#include <hip/hip_cooperative_groups.h>
#include <cstdio>
namespace cg = cooperative_groups;


#define USE_XCC_MAP 0
#define REP_PREP 1
#define REP_MOD 1
#define REP_NORM 1
#define REP_INPROJ 1
#define REP_ATTN 1
#define REP_GLU 1
#define REP_OUT0 1
typedef unsigned short u16;
using bf16x8 = __attribute__((ext_vector_type(8))) short;
using s16x4  = __attribute__((ext_vector_type(4))) short;
using f32x4  = __attribute__((ext_vector_type(4))) float;
using f32x16 = __attribute__((ext_vector_type(16))) float;
using u32x2  = __attribute__((ext_vector_type(2))) unsigned;
using u32x4  = __attribute__((ext_vector_type(4))) unsigned;
typedef __bf16 bf16_2 __attribute__((ext_vector_type(2)));
typedef float float_2 __attribute__((ext_vector_type(2)));
#define DI __device__ __forceinline__

constexpr int D = 1024, NB = 8, SEQ = 2048, DEPTH = 4, DB = 128, DS = 8;
constexpr int NTOK_P = NB * SEQ;
constexpr int NTOK = NTOK_P + DB * DS;
constexpr int INW = 2304;
constexpr int NROWS_C = NB + DB;
constexpr int PAST = 8192;
constexpr int TCH = 16;
constexpr int NCH_P = NTOK_P / TCH;
constexpr size_t O_KP = 17825792, O_VP = 18350080, O_SRP = 18874368, O_SIP = 18939904,
                 O_KS = 19005440, O_VS = 27394048, O_SRS = 35782656, O_SIS = 36831232;

struct Params {
  const float *x_prompt, *x_sample, *cache_k, *cache_v, *st_re, *st_im, *c_prompt, *c_sample,
      *norm_g, *w_ada, *b_ada, *w_in, *sinks, *a_re, *a_im, *log_dt, *b_re, *b_im, *c_re, *c_im,
      *ssm_d, *w_glu, *b_glu, *w_out, *final_g;
  float* out;
  char* ws;
  int phase_lo, phase_hi;
};
constexpr size_t al256(size_t x) { return (x + 255) & ~(size_t)255; }
constexpr int LDA = 1088;
constexpr int LDH = 576;
constexpr int LDV = 2112;
constexpr int LDB1 = 320;
constexpr int LDB2 = 448;
constexpr size_t W_WT_IN = 0;
constexpr size_t W_WT_GLU = W_WT_IN + al256((size_t)4 * 2304 * LDA * 2);
constexpr size_t W_WT_OUT = W_WT_GLU + al256((size_t)4 * 512 * LDH * 2);
constexpr size_t W_SC = W_WT_OUT + al256((size_t)4 * 1024 * LDA * 2);
constexpr size_t W_MOD = W_SC + al256((size_t)256 * 1024 * 2);
constexpr size_t W_MIX = W_MOD + al256((size_t)4 * NROWS_C * 3072 * 4);
constexpr size_t W_HN = W_MIX;
constexpr size_t W_WT_ADA = W_MIX;
constexpr size_t W_Q = W_MIX + al256((size_t)NTOK * LDA * 2);
constexpr size_t W_YG = W_Q + al256((size_t)NTOK * LDH * 2);
constexpr size_t W_K = W_YG + al256((size_t)NTOK * LDH * 2);
constexpr size_t W_VT = W_K + al256((size_t)NTOK * 128 * 2);
constexpr size_t W_ZA = W_VT + al256(((size_t)NB * 128 * LDV + (size_t)DB * 128 * 8) * 2);
constexpr size_t W_U = W_ZA + al256((size_t)NTOK * LDH * 2);
constexpr size_t W_ZS = W_U + al256((size_t)NTOK * LDH * 2);
constexpr size_t W_BT1 = W_ZS + al256((size_t)NTOK * LDH * 2);
constexpr size_t W_BT2 = W_BT1 + al256((size_t)128 * 128 * LDB1 * 2);
constexpr size_t W_APOW = W_BT2 + al256((size_t)128 * 256 * LDB2 * 2);
constexpr size_t W_CARRY_P = W_APOW + al256((size_t)128 * 256 * 4);
constexpr size_t W_CARRY_S = W_CARRY_P + al256((size_t)NCH_P * 32 * 128 * 2);
constexpr size_t W_ROPE = W_CARRY_S + al256((size_t)DB * 32 * 128 * 2);
constexpr size_t W_BAR = W_ROPE + al256((size_t)2 * 2056 * 8 * 4);
constexpr size_t W_QUEUE = W_BAR + (size_t)3456 * 4;
constexpr size_t W_TOTAL = W_BAR + al256((size_t)(3456 + 4 * 64) * 4);


DI int TID() { int t = threadIdx.x; asm volatile("" : "+v"(t)); return t; }
DI int BID() { int b = blockIdx.x; asm volatile("" : "+s"(b)); return b; }
DI char* WS(const Params& p) { size_t z = 0; asm volatile("" : "+s"(z)); return p.ws + z; }
DI float* OUTP(const Params& p) { size_t z = 0; asm volatile("" : "+s"(z)); return p.out + z; }

DI unsigned pack2(float a, float b) {
  float_2 f = {a, b};
  bf16_2 r = __builtin_convertvector(f, bf16_2);
  return __builtin_bit_cast(unsigned, r);
}
DI u16 f2bf(float a) { return (u16)(pack2(a, 0.f) & 0xffffu); }
DI float bf2f(u16 v) { return __uint_as_float(((unsigned)v) << 16); }
DI float silu_f(float x) { return x / (1.f + __expf(-x)); }
DI float sigmoid_f(float x) { return 1.f / (1.f + __expf(-x)); }
DI float gelu_tanh(float x) {
  float u = 0.7978845608028654f * (x + 0.044715f * x * x * x);
  return x / (1.f + __expf(-2.f * u));
}
DI const float* xrow_in(const Params& p, int m) {
  return m < NTOK_P ? p.x_prompt + (size_t)m * D : p.x_sample + (size_t)(m - NTOK_P) * D;
}
DI int brow_of(int m) { return m < NTOK_P ? (m >> 11) : NB + ((m - NTOK_P) >> 3); }
template <int MI, class AL, class EP>
DI void gemm_tile(u16* sm, int m0, int n0, int K, AL al, const u16* __restrict__ Bt, int ldb,
                  int bskip_at, int bskip, EP ep) {
  constexpr int BM = 32 * MI;
  u16* As = sm;
  u16* Bs = sm + 2 * BM * 72;
  const int tid = TID(), lane = tid & 63, wid = tid >> 6;
  const int wr = wid >> 1, wc = wid & 1, fr = lane & 15, fq = lane >> 4;
  const int lrow = tid >> 3, lk = (tid & 7) * 8;
  f32x4 acc[MI][4];
#pragma unroll
  for (int m = 0; m < MI; ++m)
#pragma unroll
    for (int n = 0; n < 4; ++n) acc[m][n] = f32x4{0.f, 0.f, 0.f, 0.f};
  bf16x8 pa0[MI], pb0[4], pa1[MI], pb1[4];
  const int nk = K >> 6;
  auto gload = [&](bf16x8* pa, bf16x8* pb, int kt) {
    int k = kt * 64 + lk;
    int kb = k + (k >= bskip_at ? bskip : 0);
#pragma unroll
    for (int i = 0; i < MI; ++i) pa[i] = al(m0 + lrow + 32 * i, k);
#pragma unroll
    for (int i = 0; i < 4; ++i) pb[i] = *(const bf16x8*)(Bt + (size_t)(n0 + lrow + 32 * i) * ldb + kb);
  };
  auto lstore = [&](const bf16x8* pa, const bf16x8* pb, int buf) {
#pragma unroll
    for (int i = 0; i < MI; ++i) *(bf16x8*)(As + buf * BM * 72 + (lrow + 32 * i) * 72 + lk) = pa[i];
#pragma unroll
    for (int i = 0; i < 4; ++i) *(bf16x8*)(Bs + buf * 9216 + (lrow + 32 * i) * 72 + lk) = pb[i];
  };
  auto compute = [&](int cur) {
    const u16* Ac = As + cur * BM * 72 + (wr * MI * 16 + fr) * 72 + fq * 8;
    const u16* Bc = Bs + cur * 9216 + (wc * 64 + fr) * 72 + fq * 8;
    bf16x8 af[2][MI], bv[2][4];
#pragma unroll
    for (int kk = 0; kk < 2; ++kk) {
#pragma unroll
      for (int n = 0; n < 4; ++n) bv[kk][n] = *(const bf16x8*)(Bc + n * 16 * 72 + kk * 32);
#pragma unroll
      for (int m = 0; m < MI; ++m) af[kk][m] = *(const bf16x8*)(Ac + m * 16 * 72 + kk * 32);
    }
    __builtin_amdgcn_sched_barrier(0);
#pragma unroll
    for (int kk = 0; kk < 2; ++kk)
#pragma unroll
      for (int m = 0; m < MI; ++m)
#pragma unroll
        for (int n = 0; n < 4; ++n)
          acc[m][n] = __builtin_amdgcn_mfma_f32_16x16x32_bf16(af[kk][m], bv[kk][n], acc[m][n], 0, 0, 0);
    __builtin_amdgcn_sched_barrier(0);
  };
  gload(pa0, pb0, 0);
  gload(pa1, pb1, 1);
  lstore(pa0, pb0, 0);
  __syncthreads();
  int kt = 0;
  for (; kt + 2 < nk; kt += 2) {
    gload(pa0, pb0, kt + 2);
    compute(0);
    lstore(pa1, pb1, 1);
    __syncthreads();
    gload(pa1, pb1, kt + 3);
    compute(1);
    lstore(pa0, pb0, 0);
    __syncthreads();
  }
  compute(0);
  lstore(pa1, pb1, 1);
  __syncthreads();
  compute(1);
  __syncthreads();
  float* Cs = (float*)sm;
#pragma unroll
  for (int m = 0; m < MI; ++m)
#pragma unroll
    for (int n = 0; n < 4; ++n)
#pragma unroll
      for (int j = 0; j < 4; ++j)
        Cs[(wr * MI * 16 + m * 16 + fq * 4 + j) * 132 + wc * 64 + n * 16 + fr] = acc[m][n][j];
  __syncthreads();
  ep(Cs);
  __syncthreads();
}
template <int BM, class F>
DI void for_chunks(F f) {
  const int tid = TID();
#pragma unroll 2
  for (int it = 0; it < BM / 16; ++it) {
    int idx = tid + 256 * it;
    f(idx >> 4, (idx & 15) * 8);
  }
}
DI void ld8(const float* s, float* v) {
  float4 a = *(const float4*)s, b = *(const float4*)(s + 4);
  v[0] = a.x; v[1] = a.y; v[2] = a.z; v[3] = a.w; v[4] = b.x; v[5] = b.y; v[6] = b.z; v[7] = b.w;
}
DI void st8(float* d, const float* v) {
  *(float4*)d = float4{v[0], v[1], v[2], v[3]};
  *(float4*)(d + 4) = float4{v[4], v[5], v[6], v[7]};
}
DI void st8bf(u16* d, const float* v) {
  u32x4 o = {pack2(v[0], v[1]), pack2(v[2], v[3]), pack2(v[4], v[5]), pack2(v[6], v[7])};
  *(u32x4*)d = o;
}
DI void ld8bf(const u16* s, float* v) {
  u32x4 o = *(const u32x4*)s;
#pragma unroll
  for (int e = 0; e < 4; ++e) { v[2 * e] = __uint_as_float(o[e] << 16); v[2 * e + 1] = __uint_as_float(o[e] & 0xffff0000u); }
}

DI void transpose_tile(float* tl, const float* __restrict__ src, int ldn, u16* __restrict__ dst, int ldk, int kt, int nt) {
  const int tid = TID();
#pragma unroll
  for (int i = 0; i < 4; ++i) {
    int kk = (tid >> 4) + 16 * i, c4 = (tid & 15) * 4;
    float4 v = *(const float4*)(src + (size_t)(kt * 64 + kk) * ldn + nt * 64 + c4);
    tl[kk * 65 + c4 + 0] = v.x; tl[kk * 65 + c4 + 1] = v.y; tl[kk * 65 + c4 + 2] = v.z; tl[kk * 65 + c4 + 3] = v.w;
  }
  __syncthreads();
  {
    int n = tid >> 2, ks = (tid & 3) * 16;
    u32x4 o0, o1;
#pragma unroll
    for (int e = 0; e < 4; ++e) {
      o0[e] = pack2(tl[(ks + 2 * e) * 65 + n], tl[(ks + 2 * e + 1) * 65 + n]);
      o1[e] = pack2(tl[(ks + 8 + 2 * e) * 65 + n], tl[(ks + 8 + 2 * e + 1) * 65 + n]);
    }
    u16* d = dst + (size_t)(nt * 64 + n) * ldk + kt * 64 + ks;
    *(u32x4*)d = o0;
    *(u32x4*)(d + 8) = o1;
  }
  __syncthreads();
}
DI void ssm_tables(const Params& p, float* sm, int lg, int cq) {
  float* pwr = sm;            float* pwi = pwr + 17 * 64;
  float* bbr = pwi + 17 * 64; float* bbi = bbr + 1024;
  float* cr = bbi + 1024;     float* ci = cr + 1024;
  float* Kt = ci + 1024;
  const int tid = TID();
  const float dt = expf(p.log_dt[lg]);
  const float* are = p.a_re + lg * 64;
  const float* aim = p.a_im + lg * 64;
  for (int idx = tid; idx < 17 * 64; idx += 256) {
    int pp = idx & 63, tau = idx >> 6;
    float mag = expf(are[pp] * dt * (float)tau);
    float sn, cs;
    sincosf(aim[pp] * dt * (float)tau, &sn, &cs);
    pwr[idx] = mag * cs; pwi[idx] = mag * sn;
  }
  {
    int pp = tid >> 2, c0 = (tid & 3) * 4;
    float ar = are[pp], ai = aim[pp];
    float x = ar * dt, y = ai * dt;
    float sn, cs, sh, chh;
    sincosf(y, &sn, &cs);
    sincosf(0.5f * y, &sh, &chh);
    float em1 = expm1f(x);
    float nr = em1 * cs - 2.f * sh * sh;
    float ni = (em1 + 1.f) * sn;
    float den = ar * ar + ai * ai;
    float cre = (nr * ar + ni * ai) / den;
    float cim = (ni * ar - nr * ai) / den;
#pragma unroll
    for (int e = 0; e < 4; ++e) {
      float br = p.b_re[(size_t)lg * 1024 + pp * 16 + c0 + e];
      float bi = p.b_im[(size_t)lg * 1024 + pp * 16 + c0 + e];
      bbr[pp * 16 + c0 + e] = cre * br - cim * bi;
      bbi[pp * 16 + c0 + e] = cre * bi + cim * br;
    }
  }
  for (int idx = tid; idx < 1024; idx += 256) {
    cr[idx] = p.c_re[(size_t)lg * 1024 + idx];
    ci[idx] = p.c_im[(size_t)lg * 1024 + idx];
  }
  __syncthreads();
#pragma unroll 1
  for (int e = tid; e < 1024; e += 256) {
    int tau = e >> 6, cl = (e >> 4) & 3, c2 = e & 15, c = cq * 4 + cl;
    float s = 0.f;
#pragma unroll 8
    for (int pp = 0; pp < 64; ++pp) {
      float wr_ = pwr[tau * 64 + pp], wi_ = pwi[tau * 64 + pp];
      float br = bbr[pp * 16 + c2], bi = bbi[pp * 16 + c2];
      float zr = wr_ * br - wi_ * bi, zi = wr_ * bi + wi_ * br;
      s += cr[c * 64 + pp] * zr - ci[c * 64 + pp] * zi;
    }
    if (tau == 0 && c == c2) s += p.ssm_d[lg * 16 + c];
    Kt[e] = s;
  }
  __syncthreads();
  u16* bt2 = ((u16*)(WS(p) + W_BT2)) + (size_t)lg * 256 * LDB2;
#pragma unroll 1
  for (int r = 0; r < 64; ++r) {
    int t = r >> 2, cl = r & 3, c = cq * 4 + cl, n = t * 16 + c;
    {
      int k = tid, s = k >> 4, c2 = k & 15;
      float v = (s <= t) ? Kt[((t - s) << 6) + (cl << 4) + c2] : 0.f;
      bt2[n * LDB2 + k] = f2bf(v);
    }
    if (tid < 128) {
      int pp = tid & 63;
      float wr_ = pwr[(t + 1) * 64 + pp], wi_ = pwi[(t + 1) * 64 + pp];
      float crr = cr[c * 64 + pp], cii = ci[c * 64 + pp];
      float v = (tid < 64) ? (crr * wr_ - cii * wi_) : -(crr * wi_ + cii * wr_);
      bt2[n * LDB2 + 256 + tid] = f2bf(v);
    }
  }
  u16* bt1 = ((u16*)(WS(p) + W_BT1)) + (size_t)lg * 128 * LDB1;
  {
    int k = tid, s = k >> 4, c = k & 15;
#pragma unroll 4
    for (int r = 0; r < 32; ++r) {
      int n = cq * 32 + r, pp = n & 63;
      float wr_ = pwr[(15 - s) * 64 + pp], wi_ = pwi[(15 - s) * 64 + pp];
      float br = bbr[pp * 16 + c], bi = bbi[pp * 16 + c];
      float v = (n < 64) ? (wr_ * br - wi_ * bi) : (wr_ * bi + wi_ * br);
      bt1[n * LDB1 + k] = f2bf(v);
    }
  }
  if (cq == 0 && tid < 64) {
    float* ap = ((float*)(WS(p) + W_APOW)) + (size_t)lg * 256;
    ap[tid] = pwr[16 * 64 + tid]; ap[64 + tid] = pwi[16 * 64 + tid];
    ap[128 + tid] = pwr[8 * 64 + tid]; ap[192 + tid] = pwi[8 * 64 + tid];
  }
  __syncthreads();
}

DI void phase_prep(const Params& p, char* smem) {
  const int tid = TID();
  constexpr int N_TAB = 512, N_ROPE = 1, N_SC = 16, N_TR = 6656, N_CP = 1024;
  constexpr int total = N_TAB + N_ROPE + N_SC + N_TR + N_CP;
  for (int it = BID(); it < total; it += gridDim.x) {
    int i = it;
    if (i < N_TAB) { ssm_tables(p, (float*)smem, i >> 2, i & 3); continue; }
    i -= N_TAB;
    if (i < N_ROPE) {
      for (int e = tid; e < 2056 * 8; e += 256) {
        int pi = e >> 3, j = e & 7;
        float pos = (float)(pi < 2048 ? pi : PAST + (pi - 2048));
        float inv = powf(500000.0f, -(float)j / 8.0f);
        float sn, cs;
        sincosf(pos * inv, &sn, &cs);
        ((float*)(WS(p) + W_ROPE))[e] = cs; ((float*)(WS(p) + W_ROPE))[2056 * 8 + e] = sn;
      }
      continue;
    }
    i -= N_ROPE;
    if (i < N_SC) {
      for (int e = tid; e < 16 * 1024; e += 256) {
        int r = i * 16 + (e >> 10), c = e & 1023;
        float v = 0.f;
        if (r < NB) v = silu_f(p.c_prompt[r * D + c]);
        else if (r < NROWS_C) v = silu_f(p.c_sample[(r - NB) * D + c]);
        ((u16*)(WS(p) + W_SC))[r * D + c] = f2bf(v);
      }
      continue;
    }
    i -= N_SC;
    if (i < N_TR) {
      float* tl = (float*)smem;
      if (i < 3072) { int l = i / 768, rem = i % 768; transpose_tile(tl, p.w_ada + (size_t)l * 1024 * 3072, 3072, ((u16*)(WS(p) + W_WT_ADA)) + (size_t)l * 3072 * LDA, LDA, rem / 48, rem % 48); }
      else if (i < 5376) { int j = i - 3072; int l = j / 576, rem = j % 576; transpose_tile(tl, p.w_in + (size_t)l * 1024 * 2304, 2304, ((u16*)(WS(p) + W_WT_IN)) + (size_t)l * 2304 * LDA, LDA, rem / 36, rem % 36); }
      else if (i < 5632) { int j = i - 5376; int l = j / 64, rem = j % 64; transpose_tile(tl, p.w_glu + (size_t)l * 512 * 512, 512, ((u16*)(WS(p) + W_WT_GLU)) + (size_t)l * 512 * LDH, LDH, rem / 8, rem % 8); }
      else { int j = i - 5632; int l = j / 256, rem = j % 256; transpose_tile(tl, p.w_out + (size_t)l * 1024 * 1024, 1024, ((u16*)(WS(p) + W_WT_OUT)) + (size_t)l * 1024 * LDA, LDA, rem / 16, rem % 16); }
      continue;
    }
    i -= N_TR;
    {
      int which = i >> 9, lb = i & 511;
      const float4* src = (const float4*)((which ? p.cache_v : p.cache_k) + (size_t)lb * 16384 + 8 * 128);
      float4* dst = (float4*)(OUTP(p) + (which ? O_VS : O_KS) + (size_t)lb * 16384);
      for (int e = tid; e < 3840; e += 256) dst[e] = src[e];
    }
  }
}
DI void phase_mod(const Params& p, char* smem) {
  constexpr int NT = 12288 / 128;
  for (int t = BID(); t < 2 * NT; t += gridDim.x) {
    int mt = t / NT, nt = t % NT;
    const int m0 = mt * 128, n0 = nt * 128;
    const u16* A = ((u16*)(WS(p) + W_SC));
    auto al = [&](int row, int k) { return *(const bf16x8*)(A + (size_t)row * D + k); };
    auto ep = [&](const float* Cs) {
      const int l = n0 / 3072, cb = n0 - l * 3072;
      float* md = ((float*)(WS(p) + W_MOD));
      for_chunks<128>([&](int row, int c8) {
        int r = m0 + row;
        if (r < NROWS_C) {
          float v[8], b[8];
          ld8(Cs + row * 132 + c8, v);
          ld8(p.b_ada + l * 3072 + cb + c8, b);
#pragma unroll
          for (int e = 0; e < 8; ++e) v[e] += b[e];
          st8(md + ((size_t)l * NROWS_C + r) * 3072 + cb + c8, v);
        }
      });
    };
    gemm_tile<4>((u16*)smem, m0, n0, 1024, al, ((u16*)(WS(p) + W_WT_ADA)), LDA, 1 << 30, 0, ep);
  }
}

DI void phase_norm(const Params& p, int l) {
  const int lane = TID() & 63, wid = TID() >> 6;
  const float* g = p.norm_g + l * D;
  for (int m = BID() * 4 + wid; m < NTOK; m += gridDim.x * 4) {
    const float* xr = (l == 0) ? xrow_in(p, m) : OUTP(p) + (size_t)m * D;
    const float* md = ((float*)(WS(p) + W_MOD)) + ((size_t)l * NROWS_C + brow_of(m)) * 3072;
    float4 v[4];
    float ss = 0.f;
#pragma unroll
    for (int i = 0; i < 4; ++i) {
      v[i] = *(const float4*)(xr + lane * 4 + 256 * i);
      ss += v[i].x * v[i].x + v[i].y * v[i].y + v[i].z * v[i].z + v[i].w * v[i].w;
    }
#pragma unroll
    for (int o = 32; o > 0; o >>= 1) ss += __shfl_xor(ss, o);
    float rstd = rsqrtf(ss * (1.f / D) + 1e-6f);
#pragma unroll
    for (int i = 0; i < 4; ++i) {
      int c = lane * 4 + 256 * i;
      float4 gg = *(const float4*)(g + c);
      float4 sh = *(const float4*)(md + c);
      float4 sc = *(const float4*)(md + 1024 + c);
      float a0 = v[i].x * rstd * gg.x * (1.f + sc.x) + sh.x;
      float a1 = v[i].y * rstd * gg.y * (1.f + sc.y) + sh.y;
      float a2 = v[i].z * rstd * gg.z * (1.f + sc.z) + sh.z;
      float a3 = v[i].w * rstd * gg.w * (1.f + sc.w) + sh.w;
      u32x2 o = {pack2(a0, a1), pack2(a2, a3)};
      *(u32x2*)(((u16*)(WS(p) + W_HN)) + (size_t)m * LDA + c) = o;
    }
  }
}
DI void phase_inproj(const Params& p, char* smem, int l, int vx, int vj) {
  constexpr int NT = INW / 128;
  constexpr int MT = NTOK / 128;
  const u16* Bt = ((u16*)(WS(p) + W_WT_IN)) + (size_t)l * INW * LDA;
  const int xcd = vx, nxb = gridDim.x >> 3;
  constexpr int PW = 9, MX = MT / 8;
  for (int i = vj; i < MX * NT; i += nxb) {
    int panel = i / (MX * PW), r = i - panel * (MX * PW);
    int mt = xcd * MX + r / PW, nt = panel * PW + r % PW;
    const int m0 = mt * 128, n0 = nt * 128;
    const u16* A = ((u16*)(WS(p) + W_HN));
    auto al = [&](int row, int k) { return *(const bf16x8*)(A + (size_t)row * LDA + k); };
    auto ep = [&](const float* Cs) {
      float* out = OUTP(p);
      if (nt < 5) {
        const float* rope = ((float*)(WS(p) + W_ROPE));
        u16* qd = ((u16*)(WS(p) + W_Q));
        u16* kd = ((u16*)(WS(p) + W_K));
        for_chunks<128>([&](int row, int c8) {
          const int m = m0 + row;
          const bool is_p = m < NTOK_P;
          int b, pos, ridx;
          if (is_p) { b = m >> 11; pos = m & 2047; ridx = pos; }
          else { int rr = m - NTOK_P; b = rr >> 3; pos = rr & 7; ridx = 2048 + pos; }
          float v[8];
          const float* c = Cs + row * 132 + c8;
          ld8(c, v);
          const int dd = c8 & 63;
          if (dd < 16) {
            float cs[8], sn[8], o[8];
            ld8(rope + ridx * 8, cs);
            ld8(rope + 2056 * 8 + ridx * 8, sn);
            if (dd == 0) { ld8(c + 8, o);
#pragma unroll
              for (int e = 0; e < 8; ++e) v[e] = v[e] * cs[e] - o[e] * sn[e];
            } else { ld8(c - 8, o);
#pragma unroll
              for (int e = 0; e < 8; ++e) v[e] = v[e] * cs[e] + o[e] * sn[e];
            }
          }
          if (nt < 4) st8bf(qd + (size_t)m * LDH + n0 + c8, v);
          else {
            st8bf(kd + (size_t)m * 128 + c8, v);
            if (is_p) { if (pos >= SEQ - 128) st8(out + O_KP + ((size_t)(l * NB + b) * 128 + (pos - (SEQ - 128))) * 128 + c8, v); }
            else st8(out + O_KS + ((size_t)(l * DB + b) * 128 + 120 + pos) * 128 + c8, v);
          }
        });
      } else if (nt == 5) {
        u16* vT = ((u16*)(WS(p) + W_VT));
        const int tid = TID();
#pragma unroll 2
        for (int it = 0; it < 8; ++it) {
          int idx = tid + 256 * it, col = idx & 127, rg = idx >> 7;
          const int m = m0 + rg * 8;
          float v[8];
#pragma unroll
          for (int e = 0; e < 8; ++e) v[e] = Cs[(rg * 8 + e) * 132 + col];
          if (m < NTOK_P) {
            int b = m >> 11, pos0 = m & 2047;
            st8bf(vT + ((size_t)(b * 128 + col)) * LDV + pos0, v);
            if (pos0 >= SEQ - 128) {
#pragma unroll
              for (int e = 0; e < 8; ++e) out[O_VP + ((size_t)(l * NB + b) * 128 + (pos0 + e - (SEQ - 128))) * 128 + col] = v[e];
            }
          } else {
            int b = (m - NTOK_P) >> 3;
            st8bf(vT + (size_t)NB * 128 * LDV + ((size_t)(b * 128 + col)) * 8, v);
#pragma unroll
            for (int e = 0; e < 8; ++e) out[O_VS + ((size_t)(l * DB + b) * 128 + 120 + e) * 128 + col] = v[e];
          }
        }
      } else {
        u16* dst; int cb;
        if (nt < 10) { dst = ((u16*)(WS(p) + W_ZA)); cb = n0 - 768; }
        else if (nt < 14) { dst = ((u16*)(WS(p) + W_U)); cb = n0 - 1280; }
        else { dst = ((u16*)(WS(p) + W_ZS)); cb = n0 - 1792; }
        const bool is_u = (nt >= 10) && (nt < 14);
        for_chunks<128>([&](int row, int c8) {
          float v[8];
          ld8(Cs + row * 132 + c8, v);
          const int c = cb + c8;
          if (is_u) st8bf(dst + ((size_t)(c >> 4) * NTOK + (m0 + row)) * 16 + (c & 15), v);
          else st8bf(dst + (size_t)(m0 + row) * LDH + c, v);
        });
      }
    };
    gemm_tile<4>((u16*)smem, m0, n0, 1024, al, Bt, LDA, 1 << 30, 0, ep);
  }
}

DI int crow(int i, int h) { return (i & 3) + 8 * (i >> 2) + 4 * h; }

template <bool SAMPLE>
DI void attn_task(const Params& p, int l, const u16* Ks, const u16* Vt, int VS, int koff, int kp0,
                  const u16* qptr, int qp, float sink, int tok_base, int head_base) {
  const int lane = TID() & 63, r = lane & 31, h = lane >> 5;
  bf16x8 qf[4];
#pragma unroll
  for (int s = 0; s < 4; ++s) qf[s] = *(const bf16x8*)(qptr + 16 * s + 8 * h);
  u16 zz[32];
#pragma unroll
  for (int i = 0; i < 16; ++i) {
    int row = crow(i, h);
    int tok, head;
    if (SAMPLE) { tok = tok_base + (row & 7); head = head_base + (row >> 3); }
    else { tok = tok_base + row; head = head_base; }
#pragma unroll
    for (int dt = 0; dt < 2; ++dt) zz[i * 2 + dt] = ((const u16*)(WS(p) + W_ZA))[(size_t)tok * LDH + head * 64 + dt * 32 + r];
  }
  f32x16 sc[5];
#pragma unroll
  for (int t = 0; t < 5; ++t) {
    f32x16 acc;
#pragma unroll
    for (int i = 0; i < 16; ++i) acc[i] = 0.f;
#pragma unroll
    for (int s = 0; s < 4; ++s) {
      bf16x8 a = *(const bf16x8*)(Ks + (koff + t * 32 + r) * 72 + 16 * s + 8 * h);
      acc = __builtin_amdgcn_mfma_f32_32x32x16_bf16(a, qf[s], acc, 0, 0, 0);
    }
    sc[t] = acc;
  }
  float m = sink;
#pragma unroll
  for (int t = 0; t < 5; ++t)
#pragma unroll
    for (int i = 0; i < 16; ++i) {
      int kp = kp0 + koff + t * 32 + crow(i, h);
      int df = qp - kp;
      bool valid = (df >= 0) && (df <= 128) && (kp >= 0);
      float s = valid ? sc[t][i] * 0.125f : -1e30f;
      sc[t][i] = s;
      m = fmaxf(m, s);
    }
  m = fmaxf(m, __shfl_xor(m, 32));
  float lsum = 0.f;
#pragma unroll
  for (int t = 0; t < 5; ++t)
#pragma unroll
    for (int i = 0; i < 16; ++i) {
      float e = __expf(sc[t][i] - m);
      sc[t][i] = e;
      lsum += e;
    }
  lsum += __shfl_xor(lsum, 32);
  float inv = 1.f / (lsum + __expf(sink - m));
  f32x16 o[2];
#pragma unroll
  for (int i = 0; i < 16; ++i) { o[0][i] = 0.f; o[1][i] = 0.f; }
#pragma unroll
  for (int t = 0; t < 5; ++t)
#pragma unroll
    for (int s = 0; s < 2; ++s) {
      u32x4 pk;
#pragma unroll
      for (int e = 0; e < 4; ++e) pk[e] = pack2(sc[t][8 * s + 2 * e], sc[t][8 * s + 2 * e + 1]);
      bf16x8 pa = __builtin_bit_cast(bf16x8, pk);
      int kb = koff + t * 32 + 16 * s + 4 * h;
#pragma unroll
      for (int dt = 0; dt < 2; ++dt) {
        const u16* vp = Vt + (dt * 32 + r) * VS + kb;
        s16x4 lo = *(const s16x4*)vp;
        s16x4 hi = *(const s16x4*)(vp + 8);
        bf16x8 vb = __builtin_shufflevector(lo, hi, 0, 1, 2, 3, 4, 5, 6, 7);
        o[dt] = __builtin_amdgcn_mfma_f32_32x32x16_bf16(pa, vb, o[dt], 0, 0, 0);
      }
    }
#pragma unroll
  for (int i = 0; i < 16; ++i) {
    int row = crow(i, h);
    float iq = __shfl(inv, row);
    int tok, head;
    if (SAMPLE) { tok = tok_base + (row & 7); head = head_base + (row >> 3); }
    else { tok = tok_base + row; head = head_base; }
#pragma unroll
    for (int dt = 0; dt < 2; ++dt) {
      int c = head * 64 + dt * 32 + r;
      float z = bf2f(zz[i * 2 + dt]);
      ((u16*)(WS(p) + W_MIX))[(size_t)tok * LDA + c] = f2bf(o[dt][i] * iq * silu_f(z));
    }
  }
}

DI void attn_prompt_item(const Params& p, char* smem, int l, int it) {
  const int tid = TID(), wid = tid >> 6, lane = tid & 63;
  const int b = it >> 6, h = (it >> 5) & 1, n = (it >> 1) & 15, half = it & 1;
  const int qb = n * 128 + half * 64, kstart = qb - 128;
  u16* Ks = (u16*)smem;
  u16* Vt = Ks + 192 * 72;
  for (int idx = tid; idx < 192 * 8; idx += 256) {
    int key = idx >> 3, ch = idx & 7, pos = kstart + key;
    bf16x8 v = {0, 0, 0, 0, 0, 0, 0, 0};
    if (pos >= 0) v = *(const bf16x8*)(((u16*)(WS(p) + W_K)) + ((size_t)(b * SEQ + pos)) * 128 + h * 64 + ch * 8);
    *(bf16x8*)(Ks + key * 72 + ch * 8) = v;
  }
  for (int idx = tid; idx < 64 * 24; idx += 256) {
    int d = idx / 24, ch = idx - d * 24, pos0 = kstart + ch * 8;
    s16x4 lo = {0, 0, 0, 0}, hi = {0, 0, 0, 0};
    if (pos0 >= 0) {
      const u16* src = ((u16*)(WS(p) + W_VT)) + ((size_t)((b * 2 + h) * 64 + d)) * LDV + pos0;
      lo = *(const s16x4*)src; hi = *(const s16x4*)(src + 4);
    }
    *(s16x4*)(Vt + d * 196 + ch * 8) = lo;
    *(s16x4*)(Vt + d * 196 + ch * 8 + 4) = hi;
  }
  __syncthreads();
  const int head = h * 4 + wid;
  const float sink = p.sinks[l * 8 + head];
#pragma unroll 1
  for (int r = 0; r < 2; ++r) {
    int q0 = qb + r * 32;
    const u16* qptr = ((u16*)(WS(p) + W_Q)) + ((size_t)(b * SEQ + q0 + (lane & 31))) * LDH + head * 64;
    attn_task<false>(p, l, Ks, Vt, 196, r * 32, kstart, qptr, q0 + (lane & 31), sink, b * SEQ + q0, head);
  }
  __syncthreads();
}

DI void attn_sample_item(const Params& p, char* smem, int l, int it) {
  const int tid = TID(), wid = tid >> 6, lane = tid & 63;
  const int b = it >> 1, h = it & 1;
  u16* Ks = (u16*)smem;
  u16* Vt = Ks + 160 * 72;
  const float* ck = p.cache_k + ((size_t)(l * DB + b)) * 16384 + h * 64;
  const float* cv = p.cache_v + ((size_t)(l * DB + b)) * 16384 + h * 64;
  for (int idx = tid; idx < 160 * 16; idx += 256) {
    int key = idx >> 4, c4 = (idx & 15) * 4;
    u32x2 o = {0u, 0u};
    if (key < 128) {
      float4 v = *(const float4*)(ck + (size_t)key * 128 + c4);
      o[0] = pack2(v.x, v.y); o[1] = pack2(v.z, v.w);
    } else if (key < 136) {
      o = *(const u32x2*)(((u16*)(WS(p) + W_K)) + ((size_t)(NTOK_P + b * 8 + key - 128)) * 128 + h * 64 + c4);
    }
    *(u32x2*)(Ks + key * 72 + c4) = o;
  }
  for (int idx = tid; idx < 128 * 16; idx += 256) {
    int key = idx >> 4, c4 = (idx & 15) * 4;
    float4 v = *(const float4*)(cv + (size_t)key * 128 + c4);
    Vt[(c4 + 0) * 164 + key] = f2bf(v.x);
    Vt[(c4 + 1) * 164 + key] = f2bf(v.y);
    Vt[(c4 + 2) * 164 + key] = f2bf(v.z);
    Vt[(c4 + 3) * 164 + key] = f2bf(v.w);
  }
  if (tid < 64) {
    int d = tid;
    const u16* src = ((u16*)(WS(p) + W_VT)) + (size_t)NB * 128 * LDV + ((size_t)((b * 2 + h) * 64 + d)) * 8;
    s16x4 lo = *(const s16x4*)src, hi = *(const s16x4*)(src + 4);
    s16x4 z = {0, 0, 0, 0};
    u16* dst = Vt + d * 164 + 128;
    *(s16x4*)dst = lo; *(s16x4*)(dst + 4) = hi;
#pragma unroll
    for (int e = 2; e < 8; ++e) *(s16x4*)(dst + 4 * e) = z;
  }
  __syncthreads();
  if (wid == 0) {
    int r = lane & 31, g = r >> 3, t = r & 7;
    const u16* qptr = ((u16*)(WS(p) + W_Q)) + ((size_t)(NTOK_P + b * 8 + t)) * LDH + (h * 4 + g) * 64;
    float sink = p.sinks[l * 8 + h * 4 + g];
    attn_task<true>(p, l, Ks, Vt, 164, 0, PAST - 128, qptr, PAST + t, sink, NTOK_P + b * 8, h * 4);
  }
  __syncthreads();
}
DI void ssm_g1_tile(const Params& p, char* smem, int l, int it) {
  const bool smp = it >= 256;
  const int g = smp ? it - 256 : (it & 31);
  const int mt = smp ? 0 : (it >> 5);
  const u16* U = ((u16*)(WS(p) + W_U));
  auto al = [&](int row, int k) {
    int tok = smp ? (NTOK_P + row * 8 + (k >> 4)) : (row * 16 + (k >> 4));
    return *(const bf16x8*)(U + ((size_t)g * NTOK + tok) * 16 + (k & 15));
  };
  const float* ap = ((float*)(WS(p) + W_APOW)) + (size_t)(l * 32 + g) * 256;
  auto ep = [&](const float* Csc) {
    float* Cs = const_cast<float*>(Csc);
    float* out = OUTP(p);
    const int tid = TID();
    if (smp) {
      u16* cr = ((u16*)(WS(p) + W_CARRY_S));
      for_chunks<128>([&](int row, int c8) {
        const int b = row, pp = c8 & 63;
        const bool im = c8 >= 64;
        float s[8], hr[8], hi[8], ar[8], ai[8], o[8];
        ld8(Cs + row * 132 + c8, s);
        size_t si = ((size_t)(l * DB + b) * 32 + g) * 64 + pp;
        ld8(p.st_re + si, hr); ld8(p.st_im + si, hi);
        ld8(ap + 128 + pp, ar); ld8(ap + 192 + pp, ai);
#pragma unroll
        for (int e = 0; e < 8; ++e) o[e] = im ? (ar[e] * hi[e] + ai[e] * hr[e] + s[e]) : (ar[e] * hr[e] - ai[e] * hi[e] + s[e]);
        st8(out + (im ? O_SIS : O_SRS) + si, o);
        st8bf(cr + ((size_t)g * DB + b) * 128 + c8, im ? hi : hr);
      });
    } else {
      const int b = mt;
      const int pp = tid & 63, sg = tid >> 6;
      const float ar = ap[pp], ai = ap[64 + pp];
      float hr = 0.f, hi = 0.f;
#pragma unroll 4
      for (int j = sg * 32; j < sg * 32 + 32; ++j) {
        float sr = Cs[j * 132 + pp], si = Cs[j * 132 + 64 + pp];
        float nr = ar * hr - ai * hi + sr, ni = ar * hi + ai * hr + si;
        hr = nr; hi = ni;
      }
      float pr = ar, pi = ai;
#pragma unroll
      for (int q = 0; q < 5; ++q) { float t = pr * pr - pi * pi; pi = 2.f * pr * pi; pr = t; }
      float* Ls = Cs + 128 * 132;
      Ls[sg * 128 + pp] = hr; Ls[sg * 128 + 64 + pp] = hi;
      __syncthreads();
      float cr_ = 0.f, ci_ = 0.f;
      for (int s2 = 0; s2 < sg; ++s2) {
        float lr = Ls[s2 * 128 + pp], li = Ls[s2 * 128 + 64 + pp];
        float nr = pr * cr_ - pi * ci_ + lr, ni = pr * ci_ + pi * cr_ + li;
        cr_ = nr; ci_ = ni;
      }
      hr = cr_; hi = ci_;
#pragma unroll 4
      for (int j = sg * 32; j < sg * 32 + 32; ++j) {
        float sr = Cs[j * 132 + pp], si = Cs[j * 132 + 64 + pp];
        Cs[j * 132 + pp] = hr; Cs[j * 132 + 64 + pp] = hi;
        float nr = ar * hr - ai * hi + sr, ni = ar * hi + ai * hr + si;
        hr = nr; hi = ni;
      }
      if (sg == 3) {
        out[O_SRP + ((size_t)(l * NB + b) * 32 + g) * 64 + pp] = hr;
        out[O_SIP + ((size_t)(l * NB + b) * 32 + g) * 64 + pp] = hi;
      }
      __syncthreads();
      u16* cr = ((u16*)(WS(p) + W_CARRY_P));
      for_chunks<128>([&](int row, int c8) {
        float v[8];
        ld8(Cs + row * 132 + c8, v);
        st8bf(cr + ((size_t)g * NCH_P + (b * 128 + row)) * 128 + c8, v);
      });
    }
  };
  const u16* Bt = ((u16*)(WS(p) + W_BT1)) + (size_t)(l * 32 + g) * 128 * LDB1 + (smp ? 128 : 0);
  gemm_tile<4>((u16*)smem, mt * 128, 0, smp ? 128 : 256, al, Bt, LDB1, 1 << 30, 0, ep);
}

DI void ssm_y_tile(const Params& p, char* smem, int l, int it) {
  {
    const bool smp = it >= 512;
    int g, mt, nt;
    if (smp) { g = it - 512; mt = 0; nt = 0; }
    else { g = it & 31; nt = (it >> 5) & 1; mt = it >> 6; }
    const int KU = (smp || nt == 0) ? 128 : 256;
    const int m0 = mt * 128, n0 = nt * 128;
    const u16* U = ((u16*)(WS(p) + W_U));
    const u16* CR = smp ? ((u16*)(WS(p) + W_CARRY_S)) : ((u16*)(WS(p) + W_CARRY_P));
    auto al = [&](int row, int k) {
      if (k < KU) {
        int tok = smp ? (NTOK_P + row * 8 + (k >> 4)) : (row * 16 + (k >> 4));
        return *(const bf16x8*)(U + ((size_t)g * NTOK + tok) * 16 + (k & 15));
      } else {
        return *(const bf16x8*)(CR + ((size_t)g * (smp ? DB : NCH_P) + row) * 128 + (k - KU));
      }
    };
    auto ep = [&](const float* Cs) {
      u16* yg = ((u16*)(WS(p) + W_YG));
      for_chunks<128>([&](int row, int c8) {
        int col = n0 + c8, t = col >> 4, c0 = col & 15;
        int tok = smp ? (NTOK_P + (m0 + row) * 8 + t) : ((m0 + row) * 16 + t);
        float v[8];
        ld8(Cs + row * 132 + c8, v);
#pragma unroll
        for (int e = 0; e < 8; ++e) v[e] = gelu_tanh(v[e]);
        st8bf(yg + (size_t)tok * LDH + g * 16 + c0, v);
      });
    };
    const u16* Bt = ((u16*)(WS(p) + W_BT2)) + (size_t)(l * 32 + g) * 256 * LDB2;
    gemm_tile<4>((u16*)smem, m0, n0, KU + 128, al, Bt, LDB2, KU, 256 - KU, ep);
  }
}

DI void phase_attn(const Params& p, char* smem, int l, int* q_slot) {
  unsigned* ctr = (unsigned*)(WS(p) + W_QUEUE) + l * 64;
  for (;;) {
    if (threadIdx.x == 0) *q_slot = (int)atomicAdd(ctr, 1u);
    __syncthreads();
    const int it = __builtin_amdgcn_readfirstlane(*q_slot);
    __syncthreads();
    if (it >= 1056) break;
    if (it < 256) {
      const int b = it >> 5, g = it & 31;
      ssm_g1_tile(p, smem, l, it);
      __threadfence_block();
      asm volatile("s_waitcnt vmcnt(0)" ::: "memory");
      __syncthreads();
      ssm_y_tile(p, smem, l, b * 64 + g);
      ssm_y_tile(p, smem, l, b * 64 + 32 + g);
    } else if (it < 768) {
      attn_prompt_item(p, smem, l, it - 256);
    } else if (it < 1024) {
      attn_sample_item(p, smem, l, it - 768);
    } else {
      ssm_g1_tile(p, smem, l, 256 + (it - 1024));
      __threadfence_block();
      asm volatile("s_waitcnt vmcnt(0)" ::: "memory");
      __syncthreads();
      ssm_y_tile(p, smem, l, 512 + (it - 1024));
    }
  }
}

DI void phase_glu(const Params& p, char* smem, int l, int vx, int vj) {
  constexpr int MI = 2, BM = 32 * MI;
  constexpr int MT = NTOK / BM, NT = 4;
  const u16* Bt = ((u16*)(WS(p) + W_WT_GLU)) + (size_t)l * 512 * LDH;
  const int xcd = vx, nxb = gridDim.x >> 3;
  constexpr int MX = MT / 8;
  for (int i = vj; i < MX * NT; i += nxb) {
    int mt = xcd * MX + i / NT, nt = i % NT;
    const int m0 = mt * BM, n0 = nt * 128;
    const u16* A = ((u16*)(WS(p) + W_YG));
    auto al = [&](int row, int k) { return *(const bf16x8*)(A + (size_t)row * LDH + k); };
    auto ep = [&](const float* Cs) {
      const u16* yg = ((u16*)(WS(p) + W_YG));
      const u16* zs = ((u16*)(WS(p) + W_ZS));
      u16* mix = ((u16*)(WS(p) + W_MIX));
      for_chunks<BM>([&](int row, int c8) {
        const int m = m0 + row, col = n0 + c8;
        float v[8], y[8], z[8], bg[8];
        ld8(Cs + row * 132 + c8, v);
        ld8bf(yg + (size_t)m * LDH + col, y);
        ld8bf(zs + (size_t)m * LDH + col, z);
        ld8(p.b_glu + l * 512 + col, bg);
#pragma unroll
        for (int e = 0; e < 8; ++e) v[e] = y[e] * sigmoid_f(v[e] + bg[e]) * silu_f(z[e]);
        st8bf(mix + (size_t)m * LDA + 512 + col, v);
      });
    };
    gemm_tile<MI>((u16*)smem, m0, n0, 512, al, Bt, LDH, 1 << 30, 0, ep);
  }
}

template <int MI>
DI void outproj_tile(const Params& p, char* smem, int l, int m0, int n0) {
  constexpr int BM = 32 * MI;
  const u16* Bt = ((u16*)(WS(p) + W_WT_OUT)) + (size_t)l * 1024 * LDA;
  const u16* A = ((u16*)(WS(p) + W_MIX));
  auto al = [&](int row, int k) { return *(const bf16x8*)(A + (size_t)row * LDA + k); };
  auto ep = [&](const float* Cs) {
    float* out = OUTP(p);
    const float* md = ((float*)(WS(p) + W_MOD));
    for_chunks<BM>([&](int row, int c8) {
      const int m = m0 + row, col = n0 + c8;
      float v[8], gt[8], xo[8];
      ld8(Cs + row * 132 + c8, v);
      ld8(md + ((size_t)l * NROWS_C + brow_of(m)) * 3072 + 2048 + col, gt);
      ld8((l == 0) ? xrow_in(p, m) + col : out + (size_t)m * D + col, xo);
#pragma unroll
      for (int e = 0; e < 8; ++e) v[e] = xo[e] + gt[e] * v[e];
      st8(out + (size_t)m * D + col, v);
    });
  };
  gemm_tile<MI>((u16*)smem, m0, n0, 1024, al, Bt, LDA, 1 << 30, 0, ep);
}
DI void phase_outproj(const Params& p, char* smem, int l, int vx, int vj) {
  const int xcd = vx, nxb = gridDim.x >> 3;
  for (int i = vj; i < 16 * 8; i += nxb) outproj_tile<4>(p, smem, l, (xcd * 16 + i / 8) * 128, (i % 8) * 128);
  for (int i = vj; i < 4 * 8; i += nxb) outproj_tile<1>(p, smem, l, NTOK_P + (xcd * 4 + i / 8) * 32, (i % 8) * 128);
}

DI void phase_final(const Params& p) {
  const int lane = TID() & 63, wid = TID() >> 6;
  for (int m = BID() * 4 + wid; m < NTOK; m += gridDim.x * 4) {
    float* xr = OUTP(p) + (size_t)m * D;
    float4 v[4];
    float ss = 0.f;
#pragma unroll
    for (int i = 0; i < 4; ++i) {
      v[i] = *(const float4*)(xr + lane * 4 + 256 * i);
      ss += v[i].x * v[i].x + v[i].y * v[i].y + v[i].z * v[i].z + v[i].w * v[i].w;
    }
#pragma unroll
    for (int o = 32; o > 0; o >>= 1) ss += __shfl_xor(ss, o);
    float rstd = rsqrtf(ss * (1.f / D) + 1e-6f);
#pragma unroll
    for (int i = 0; i < 4; ++i) {
      int c = lane * 4 + 256 * i;
      float4 gg = *(const float4*)(p.final_g + c);
      float4 o = {v[i].x * rstd * gg.x, v[i].y * rstd * gg.y, v[i].z * rstd * gg.z, v[i].w * rstd * gg.w};
      *(float4*)(xr + c) = o;
    }
  }
}

#define XB_TMO      128
#define XB_XCNT(j)  (256  + 64 * (j))
#define XB_XSUB(j)  (1280 + 64 * (j))
#define XB_XGEN(j)  (2304 + 64 * (j))
#define XB_TOP      3328
#define XB_TOPGEN   3392
#define XCD_BAR_WORDS 3456
#define XB_SPIN_CAP (1u << 18)
#define LAS __attribute__((address_space(3)))
DI unsigned xb_ld(unsigned* p)              { return __hip_atomic_load(p, __ATOMIC_RELAXED, __HIP_MEMORY_SCOPE_AGENT); }
DI unsigned xb_add(unsigned* p, unsigned v) { return __hip_atomic_fetch_add(p, v, __ATOMIC_RELAXED, __HIP_MEMORY_SCOPE_AGENT); }
DI unsigned xb_xcc_id() { return (unsigned)__builtin_amdgcn_s_getreg((3 << 11) | 20) & 0xFu; }
#define XB_SPIN(cond, bar) do { unsigned _sp = 0; while (cond) { __builtin_amdgcn_s_sleep(1); \
    if ((++_sp & 255u) == 0u) { if (xb_ld(&(bar)[XB_TMO])) break; if (_sp > XB_SPIN_CAP) { atomicAdd(&(bar)[XB_TMO], 1u); break; } } } } while (0)
struct XcdBarrier { unsigned* bar; unsigned x; volatile LAS unsigned* st; };
DI XcdBarrier xcd_barrier_post(unsigned* bar, volatile LAS unsigned* st) {
  XcdBarrier b; b.bar = bar; b.x = xb_xcc_id(); b.st = st;
  if (threadIdx.x == 0) st[2] = xb_add(&bar[XB_XCNT(b.x)], 1u);
  return b;
}
DI void xcd_barrier_complete(unsigned* bar, unsigned x, unsigned& nloc, unsigned& nx, unsigned& bal) {
  const unsigned G = gridDim.x * gridDim.y * gridDim.z;
  unsigned sum, cnt, mine, sp = 0u, even;
  for (;;) {
    sum = 0u; cnt = 0u; mine = 0u; even = 1u;
#pragma unroll
    for (unsigned j = 0; j < 16; ++j) { const unsigned c = xb_ld(&bar[XB_XCNT(j)]); sum += c; cnt += (c > 0u) ? 1u : 0u; mine = (j == x) ? c : mine;
      if (c != ((j < 8u) ? (G >> 3) : 0u)) even = 0u; }
    if (sum == G) break;
    __builtin_amdgcn_s_sleep(1);
    if ((++sp & 255u) == 0u) { if (xb_ld(&bar[XB_TMO])) break; if (sp > XB_SPIN_CAP) { atomicAdd(&bar[XB_TMO], 1u); break; } }
  }
  nloc = mine > 0u ? mine : 1u; nx = cnt > 0u ? cnt : 1u;
  bal = (sum == G && even) ? 2u : 1u;
}
DI void xcd_barrier(const XcdBarrier& b) {
  asm volatile("s_waitcnt vmcnt(0)" ::: "memory");
  __syncthreads();
  if (threadIdx.x == 0) {
    unsigned* bar = b.bar;
    __builtin_amdgcn_s_waitcnt(0);
    unsigned nloc = b.st[0], nx = b.st[1];
    if (nloc == 0u) { unsigned bal; xcd_barrier_complete(bar, b.x, nloc, nx, bal); b.st[0] = nloc; b.st[1] = nx; b.st[3] = bal; }
    const unsigned old = xb_add(&bar[XB_XSUB(b.x)], 1u);
    const unsigned gen = old / nloc;
    if (old + 1u == (gen + 1u) * nloc) {
      __builtin_amdgcn_fence(__ATOMIC_RELEASE, "agent");
      asm volatile("s_waitcnt vmcnt(0)" ::: "memory");
      const unsigned og = xb_add(&bar[XB_TOP], 1u);
      const unsigned tg = og / nx;
      if (og + 1u == (tg + 1u) * nx) xb_add(&bar[XB_TOPGEN], 1u);
      else XB_SPIN(xb_ld(&bar[XB_TOPGEN]) == tg, bar);
      __builtin_amdgcn_fence(__ATOMIC_ACQUIRE, "agent");
      xb_add(&bar[XB_XGEN(b.x)], 1u);
      asm volatile("s_waitcnt vmcnt(0)" ::: "memory");
    } else {
      XB_SPIN(xb_ld(&bar[XB_XGEN(b.x)]) == gen, bar);
      __builtin_amdgcn_fence(__ATOMIC_ACQUIRE, "agent");
      asm volatile("s_waitcnt vmcnt(0)" ::: "memory");
    }
  }
  __syncthreads();
}
constexpr int N_PHASES = 2 + 5 * DEPTH + 1;

__global__ void __launch_bounds__(256, 2) fwd_kernel(Params p) {
  __shared__ __attribute__((aligned(16))) char smem[73728];
  __shared__ uint4 xb_words;
  __shared__ int q_slot;
  cg::grid_group grid = cg::this_grid();
  if (threadIdx.x == 0) xb_words = make_uint4(0u, 0u, 0u, 0u);
  __syncthreads();
  XcdBarrier xb = xcd_barrier_post((unsigned*)(p.ws + W_BAR), (volatile LAS unsigned*)&xb_words);
  if (p.phase_lo < 0) grid.sync();
  for (int ph = p.phase_lo; ph < p.phase_hi; ++ph) {
    int vx = BID() & 7, vj = BID() >> 3;
    if (USE_XCC_MAP && xb.st[3] == 2u) { vx = (int)xb.x; vj = (int)xb.st[2]; }
    vx = __builtin_amdgcn_readfirstlane(vx); vj = __builtin_amdgcn_readfirstlane(vj);
    if (ph == 0) { for (int r = 0; r < REP_PREP; ++r) phase_prep(p, smem); }
    else if (ph == 1) { for (int r = 0; r < REP_MOD; ++r) phase_mod(p, smem); }
    else if (ph == N_PHASES - 1) phase_final(p);
    else {
      int l = (ph - 2) / 5, s = (ph - 2) % 5;
      switch (s) {
        case 0: for (int r = 0; r < REP_NORM; ++r) phase_norm(p, l); break;
        case 1: for (int r = 0; r < REP_INPROJ; ++r) phase_inproj(p, smem, l, vx, vj); break;
        case 2: phase_attn(p, smem, l, &q_slot); break;
        case 3: for (int r = 0; r < REP_GLU; ++r) phase_glu(p, smem, l, vx, vj); break;
        default: for (int r = 0; r < (l == 0 ? REP_OUT0 : 1); ++r) phase_outproj(p, smem, l, vx, vj); break;
      }
    }
    if (ph + 1 < p.phase_hi) xcd_barrier(xb);
  }
}

extern "C" void kernel_launch(void* const* d_in, const int* in_sizes, int n_in, void* d_out, int out_size,
                              void* d_ws, size_t ws_size, hipStream_t stream) {
  static int grid_blocks = 0;
  if (!grid_blocks) {
    int dev = 0, cus = 0, per_cu = 0;
    hipGetDevice(&dev);
    hipDeviceGetAttribute(&cus, hipDeviceAttributeMultiprocessorCount, dev);
    hipOccupancyMaxActiveBlocksPerMultiprocessor(&per_cu, fwd_kernel, 256, 0);
    if (per_cu > 2) per_cu = 2;
    if (per_cu < 1) per_cu = 1;
    grid_blocks = cus * per_cu;
  }
  Params p{};
  const float** fp = (const float**)&p;
  for (int i = 0; i < 25; ++i) fp[i] = (const float*)d_in[i];
  p.out = (float*)d_out;
  p.ws = (char*)d_ws;
  if (W_TOTAL > ws_size) fprintf(stderr, "workspace too small: need %zu have %zu\n", (size_t)W_TOTAL, ws_size);
  hipMemsetAsync((char*)d_ws + W_BAR, 0, (size_t)(3456 + 4 * 64) * 4, stream);
  p.phase_lo = 0; p.phase_hi = N_PHASES;
  void* args[] = {&p};
  hipError_t e = hipLaunchCooperativeKernel((void*)fwd_kernel, dim3(grid_blocks), dim3(256), args, 0, stream);
  if (e != hipSuccess) fprintf(stderr, "cooperative launch failed: %s (grid %d)\n", hipGetErrorString(e), grid_blocks);
}
```

```cpp
#include <hip/hip_runtime.h>
#include <hip/hip_cooperative_groups.h>
#include <cstdio>
namespace cg = cooperative_groups;


#define USE_XCC_MAP 0
#define REP_PREP 1
#define REP_MOD 1
#define REP_NORM 1
#define REP_INPROJ 1
#define REP_ATTN 1
#define REP_GLU 1
#define REP_OUT0 1
typedef unsigned short u16;
using bf16x8 = __attribute__((ext_vector_type(8))) short;
using s16x4  = __attribute__((ext_vector_type(4))) short;
using f32x4  = __attribute__((ext_vector_type(4))) float;
using f32x16 = __attribute__((ext_vector_type(16))) float;
using u32x2  = __attribute__((ext_vector_type(2))) unsigned;
using u32x4  = __attribute__((ext_vector_type(4))) unsigned;
typedef __bf16 bf16_2 __attribute__((ext_vector_type(2)));
typedef float float_2 __attribute__((ext_vector_type(2)));
#define DI __device__ __forceinline__

constexpr int D = 1024, NB = 8, SEQ = 2048, DEPTH = 4, DB = 128, DS = 8;
constexpr int NTOK_P = NB * SEQ;
constexpr int NTOK = NTOK_P + DB * DS;
constexpr int INW = 2304;
constexpr int NROWS_C = NB + DB;
constexpr int PAST = 8192;
constexpr int TCH = 16;
constexpr int NCH_P = NTOK_P / TCH;
constexpr size_t O_KP = 17825792, O_VP = 18350080, O_SRP = 18874368, O_SIP = 18939904,
                 O_KS = 19005440, O_VS = 27394048, O_SRS = 35782656, O_SIS = 36831232;

struct Params {
  const float *x_prompt, *x_sample, *cache_k, *cache_v, *st_re, *st_im, *c_prompt, *c_sample,
      *norm_g, *w_ada, *b_ada, *w_in, *sinks, *a_re, *a_im, *log_dt, *b_re, *b_im, *c_re, *c_im,
      *ssm_d, *w_glu, *b_glu, *w_out, *final_g;
  float* out;
  char* ws;
  int phase_lo, phase_hi;
};
constexpr size_t al256(size_t x) { return (x + 255) & ~(size_t)255; }
constexpr int LDA = 1088;
constexpr int LDH = 576;
constexpr int LDV = 2112;
constexpr int LDB1 = 320;
constexpr int LDB2 = 448;
constexpr size_t W_WT_IN = 0;
constexpr size_t W_WT_GLU = W_WT_IN + al256((size_t)4 * 2304 * LDA * 2);
constexpr size_t W_WT_OUT = W_WT_GLU + al256((size_t)4 * 512 * LDH * 2);
constexpr size_t W_SC = W_WT_OUT + al256((size_t)4 * 1024 * LDA * 2);
constexpr size_t W_MOD = W_SC + al256((size_t)256 * 1024 * 2);
constexpr size_t W_MIX = W_MOD + al256((size_t)4 * NROWS_C * 3072 * 4);
constexpr size_t W_HN = W_MIX;
constexpr size_t W_WT_ADA = W_MIX;
constexpr size_t W_Q = W_MIX + al256((size_t)NTOK * LDA * 2);
constexpr size_t W_YG = W_Q + al256((size_t)NTOK * LDH * 2);
constexpr size_t W_K = W_YG + al256((size_t)NTOK * LDH * 2);
constexpr size_t W_VT = W_K + al256((size_t)NTOK * 128 * 2);
constexpr size_t W_ZA = W_VT + al256(((size_t)NB * 128 * LDV + (size_t)DB * 128 * 8) * 2);
constexpr size_t W_U = W_ZA + al256((size_t)NTOK * LDH * 2);
constexpr size_t W_ZS = W_U + al256((size_t)NTOK * LDH * 2);
constexpr size_t W_BT1 = W_ZS + al256((size_t)NTOK * LDH * 2);
constexpr size_t W_BT2 = W_BT1 + al256((size_t)128 * 128 * LDB1 * 2);
constexpr size_t W_APOW = W_BT2 + al256((size_t)128 * 256 * LDB2 * 2);
constexpr size_t W_CARRY_P = W_APOW + al256((size_t)128 * 256 * 4);
constexpr size_t W_CARRY_S = W_CARRY_P + al256((size_t)NCH_P * 32 * 128 * 2);
constexpr size_t W_ROPE = W_CARRY_S + al256((size_t)DB * 32 * 128 * 2);
constexpr size_t W_BAR = W_ROPE + al256((size_t)2 * 2056 * 8 * 4);
constexpr size_t W_QUEUE = W_BAR + (size_t)3456 * 4;
constexpr size_t W_TOTAL = W_BAR + al256((size_t)(3456 + 4 * 16 * 64) * 4);


DI int TID() { int t = threadIdx.x; asm volatile("" : "+v"(t)); return t; }
DI int BID() { int b = blockIdx.x; asm volatile("" : "+s"(b)); return b; }
DI char* WS(const Params& p) { size_t z = 0; asm volatile("" : "+s"(z)); return p.ws + z; }
DI float* OUTP(const Params& p) { size_t z = 0; asm volatile("" : "+s"(z)); return p.out + z; }

DI unsigned pack2(float a, float b) {
  float_2 f = {a, b};
  bf16_2 r = __builtin_convertvector(f, bf16_2);
  return __builtin_bit_cast(unsigned, r);
}
DI u16 f2bf(float a) { return (u16)(pack2(a, 0.f) & 0xffffu); }
DI float bf2f(u16 v) { return __uint_as_float(((unsigned)v) << 16); }
DI float silu_f(float x) { return x / (1.f + __expf(-x)); }
DI float sigmoid_f(float x) { return 1.f / (1.f + __expf(-x)); }
DI float gelu_tanh(float x) {
  float u = 0.7978845608028654f * (x + 0.044715f * x * x * x);
  return x / (1.f + __expf(-2.f * u));
}
DI const float* xrow_in(const Params& p, int m) {
  return m < NTOK_P ? p.x_prompt + (size_t)m * D : p.x_sample + (size_t)(m - NTOK_P) * D;
}
DI int brow_of(int m) { return m < NTOK_P ? (m >> 11) : NB + ((m - NTOK_P) >> 3); }
template <int MI, class AL, class EP>
DI void gemm_tile(u16* sm, int m0, int n0, int K, AL al, const u16* __restrict__ Bt, int ldb,
                  int bskip_at, int bskip, EP ep) {
  constexpr int BM = 32 * MI;
  u16* As = sm;
  u16* Bs = sm + 2 * BM * 72;
  const int tid = TID(), lane = tid & 63, wid = tid >> 6;
  const int wr = wid >> 1, wc = wid & 1, fr = lane & 15, fq = lane >> 4;
  const int lrow = tid >> 3, lk = (tid & 7) * 8;
  f32x4 acc[MI][4];
#pragma unroll
  for (int m = 0; m < MI; ++m)
#pragma unroll
    for (int n = 0; n < 4; ++n) acc[m][n] = f32x4{0.f, 0.f, 0.f, 0.f};
  bf16x8 pa0[MI], pb0[4], pa1[MI], pb1[4];
  const int nk = K >> 6;
  auto gload = [&](bf16x8* pa, bf16x8* pb, int kt) {
    int k = kt * 64 + lk;
    int kb = k + (k >= bskip_at ? bskip : 0);
#pragma unroll
    for (int i = 0; i < MI; ++i) pa[i] = al(m0 + lrow + 32 * i, k);
#pragma unroll
    for (int i = 0; i < 4; ++i) pb[i] = *(const bf16x8*)(Bt + (size_t)(n0 + lrow + 32 * i) * ldb + kb);
  };
  auto lstore = [&](const bf16x8* pa, const bf16x8* pb, int buf) {
#pragma unroll
    for (int i = 0; i < MI; ++i) *(bf16x8*)(As + buf * BM * 72 + (lrow + 32 * i) * 72 + lk) = pa[i];
#pragma unroll
    for (int i = 0; i < 4; ++i) *(bf16x8*)(Bs + buf * 9216 + (lrow + 32 * i) * 72 + lk) = pb[i];
  };
  auto compute = [&](int cur) {
    const u16* Ac = As + cur * BM * 72 + (wr * MI * 16 + fr) * 72 + fq * 8;
    const u16* Bc = Bs + cur * 9216 + (wc * 64 + fr) * 72 + fq * 8;
    bf16x8 af[2][MI], bv[2][4];
#pragma unroll
    for (int kk = 0; kk < 2; ++kk) {
#pragma unroll
      for (int n = 0; n < 4; ++n) bv[kk][n] = *(const bf16x8*)(Bc + n * 16 * 72 + kk * 32);
#pragma unroll
      for (int m = 0; m < MI; ++m) af[kk][m] = *(const bf16x8*)(Ac + m * 16 * 72 + kk * 32);
    }
    __builtin_amdgcn_sched_barrier(0);
#pragma unroll
    for (int kk = 0; kk < 2; ++kk)
#pragma unroll
      for (int m = 0; m < MI; ++m)
#pragma unroll
        for (int n = 0; n < 4; ++n)
          acc[m][n] = __builtin_amdgcn_mfma_f32_16x16x32_bf16(af[kk][m], bv[kk][n], acc[m][n], 0, 0, 0);
    __builtin_amdgcn_sched_barrier(0);
  };
  gload(pa0, pb0, 0);
  gload(pa1, pb1, 1);
  lstore(pa0, pb0, 0);
  __syncthreads();
  int kt = 0;
  for (; kt + 2 < nk; kt += 2) {
    gload(pa0, pb0, kt + 2);
    compute(0);
    lstore(pa1, pb1, 1);
    __syncthreads();
    gload(pa1, pb1, kt + 3);
    compute(1);
    lstore(pa0, pb0, 0);
    __syncthreads();
  }
  compute(0);
  lstore(pa1, pb1, 1);
  __syncthreads();
  compute(1);
  __syncthreads();
  float* Cs = (float*)sm;
#pragma unroll
  for (int m = 0; m < MI; ++m)
#pragma unroll
    for (int n = 0; n < 4; ++n)
#pragma unroll
      for (int j = 0; j < 4; ++j)
        Cs[(wr * MI * 16 + m * 16 + fq * 4 + j) * 132 + wc * 64 + n * 16 + fr] = acc[m][n][j];
  __syncthreads();
  ep(Cs);
  __syncthreads();
}
template <int BM, class F>
DI void for_chunks(F f) {
  const int tid = TID();
#pragma unroll 2
  for (int it = 0; it < BM / 16; ++it) {
    int idx = tid + 256 * it;
    f(idx >> 4, (idx & 15) * 8);
  }
}
DI void ld8(const float* s, float* v) {
  float4 a = *(const float4*)s, b = *(const float4*)(s + 4);
  v[0] = a.x; v[1] = a.y; v[2] = a.z; v[3] = a.w; v[4] = b.x; v[5] = b.y; v[6] = b.z; v[7] = b.w;
}
DI void st8(float* d, const float* v) {
  *(float4*)d = float4{v[0], v[1], v[2], v[3]};
  *(float4*)(d + 4) = float4{v[4], v[5], v[6], v[7]};
}
DI void st8bf(u16* d, const float* v) {
  u32x4 o = {pack2(v[0], v[1]), pack2(v[2], v[3]), pack2(v[4], v[5]), pack2(v[6], v[7])};
  *(u32x4*)d = o;
}
DI void st8bf_wt(u16* d, const float* v) {
  u32x4 o = {pack2(v[0], v[1]), pack2(v[2], v[3]), pack2(v[4], v[5]), pack2(v[6], v[7])};
  asm volatile("global_store_dwordx4 %0, %1, off sc0 sc1" :: "v"(d), "v"(o) : "memory");
}
DI void ld8bf(const u16* s, float* v) {
  u32x4 o = *(const u32x4*)s;
#pragma unroll
  for (int e = 0; e < 4; ++e) { v[2 * e] = __uint_as_float(o[e] << 16); v[2 * e + 1] = __uint_as_float(o[e] & 0xffff0000u); }
}

DI void transpose_tile(float* tl, const float* __restrict__ src, int ldn, u16* __restrict__ dst, int ldk, int kt, int nt) {
  const int tid = TID();
#pragma unroll
  for (int i = 0; i < 4; ++i) {
    int kk = (tid >> 4) + 16 * i, c4 = (tid & 15) * 4;
    float4 v = *(const float4*)(src + (size_t)(kt * 64 + kk) * ldn + nt * 64 + c4);
    tl[kk * 65 + c4 + 0] = v.x; tl[kk * 65 + c4 + 1] = v.y; tl[kk * 65 + c4 + 2] = v.z; tl[kk * 65 + c4 + 3] = v.w;
  }
  __syncthreads();
  {
    int n = tid >> 2, ks = (tid & 3) * 16;
    u32x4 o0, o1;
#pragma unroll
    for (int e = 0; e < 4; ++e) {
      o0[e] = pack2(tl[(ks + 2 * e) * 65 + n], tl[(ks + 2 * e + 1) * 65 + n]);
      o1[e] = pack2(tl[(ks + 8 + 2 * e) * 65 + n], tl[(ks + 8 + 2 * e + 1) * 65 + n]);
    }
    u16* d = dst + (size_t)(nt * 64 + n) * ldk + kt * 64 + ks;
    *(u32x4*)d = o0;
    *(u32x4*)(d + 8) = o1;
  }
  __syncthreads();
}
DI void ssm_tables(const Params& p, float* sm, int lg, int cq) {
  float* pwr = sm;            float* pwi = pwr + 17 * 64;
  float* bbr = pwi + 17 * 64; float* bbi = bbr + 1024;
  float* cr = bbi + 1024;     float* ci = cr + 1024;
  float* Kt = ci + 1024;
  const int tid = TID();
  const float dt = expf(p.log_dt[lg]);
  const float* are = p.a_re + lg * 64;
  const float* aim = p.a_im + lg * 64;
  for (int idx = tid; idx < 17 * 64; idx += 256) {
    int pp = idx & 63, tau = idx >> 6;
    float mag = expf(are[pp] * dt * (float)tau);
    float sn, cs;
    sincosf(aim[pp] * dt * (float)tau, &sn, &cs);
    pwr[idx] = mag * cs; pwi[idx] = mag * sn;
  }
  {
    int pp = tid >> 2, c0 = (tid & 3) * 4;
    float ar = are[pp], ai = aim[pp];
    float x = ar * dt, y = ai * dt;
    float sn, cs, sh, chh;
    sincosf(y, &sn, &cs);
    sincosf(0.5f * y, &sh, &chh);
    float em1 = expm1f(x);
    float nr = em1 * cs - 2.f * sh * sh;
    float ni = (em1 + 1.f) * sn;
    float den = ar * ar + ai * ai;
    float cre = (nr * ar + ni * ai) / den;
    float cim = (ni * ar - nr * ai) / den;
#pragma unroll
    for (int e = 0; e < 4; ++e) {
      float br = p.b_re[(size_t)lg * 1024 + pp * 16 + c0 + e];
      float bi = p.b_im[(size_t)lg * 1024 + pp * 16 + c0 + e];
      bbr[pp * 16 + c0 + e] = cre * br - cim * bi;
      bbi[pp * 16 + c0 + e] = cre * bi + cim * br;
    }
  }
  for (int idx = tid; idx < 1024; idx += 256) {
    cr[idx] = p.c_re[(size_t)lg * 1024 + idx];
    ci[idx] = p.c_im[(size_t)lg * 1024 + idx];
  }
  __syncthreads();
#pragma unroll 1
  for (int e = tid; e < 1024; e += 256) {
    int tau = e >> 6, cl = (e >> 4) & 3, c2 = e & 15, c = cq * 4 + cl;
    float s = 0.f;
#pragma unroll 8
    for (int pp = 0; pp < 64; ++pp) {
      float wr_ = pwr[tau * 64 + pp], wi_ = pwi[tau * 64 + pp];
      float br = bbr[pp * 16 + c2], bi = bbi[pp * 16 + c2];
      float zr = wr_ * br - wi_ * bi, zi = wr_ * bi + wi_ * br;
      s += cr[c * 64 + pp] * zr - ci[c * 64 + pp] * zi;
    }
    if (tau == 0 && c == c2) s += p.ssm_d[lg * 16 + c];
    Kt[e] = s;
  }
  __syncthreads();
  u16* bt2 = ((u16*)(WS(p) + W_BT2)) + (size_t)lg * 256 * LDB2;
#pragma unroll 1
  for (int r = 0; r < 64; ++r) {
    int t = r >> 2, cl = r & 3, c = cq * 4 + cl, n = t * 16 + c;
    {
      int k = tid, s = k >> 4, c2 = k & 15;
      float v = (s <= t) ? Kt[((t - s) << 6) + (cl << 4) + c2] : 0.f;
      bt2[n * LDB2 + k] = f2bf(v);
    }
    if (tid < 128) {
      int pp = tid & 63;
      float wr_ = pwr[(t + 1) * 64 + pp], wi_ = pwi[(t + 1) * 64 + pp];
      float crr = cr[c * 64 + pp], cii = ci[c * 64 + pp];
      float v = (tid < 64) ? (crr * wr_ - cii * wi_) : -(crr * wi_ + cii * wr_);
      bt2[n * LDB2 + 256 + tid] = f2bf(v);
    }
  }
  u16* bt1 = ((u16*)(WS(p) + W_BT1)) + (size_t)lg * 128 * LDB1;
  {
    int k = tid, s = k >> 4, c = k & 15;
#pragma unroll 4
    for (int r = 0; r < 32; ++r) {
      int n = cq * 32 + r, pp = n & 63;
      float wr_ = pwr[(15 - s) * 64 + pp], wi_ = pwi[(15 - s) * 64 + pp];
      float br = bbr[pp * 16 + c], bi = bbi[pp * 16 + c];
      float v = (n < 64) ? (wr_ * br - wi_ * bi) : (wr_ * bi + wi_ * br);
      bt1[n * LDB1 + k] = f2bf(v);
    }
  }
  if (cq == 0 && tid < 64) {
    float* ap = ((float*)(WS(p) + W_APOW)) + (size_t)lg * 256;
    ap[tid] = pwr[16 * 64 + tid]; ap[64 + tid] = pwi[16 * 64 + tid];
    ap[128 + tid] = pwr[8 * 64 + tid]; ap[192 + tid] = pwi[8 * 64 + tid];
  }
  __syncthreads();
}

DI void phase_prep(const Params& p, char* smem) {
  const int tid = TID();
  constexpr int N_TAB = 512, N_ROPE = 1, N_SC = 16, N_TR = 6656, N_CP = 1024;
  constexpr int total = N_TAB + N_ROPE + N_SC + N_TR + N_CP;
  for (int it = BID(); it < total; it += gridDim.x) {
    int i = it;
    if (i < N_TAB) { ssm_tables(p, (float*)smem, i >> 2, i & 3); continue; }
    i -= N_TAB;
    if (i < N_ROPE) {
      for (int e = tid; e < 2056 * 8; e += 256) {
        int pi = e >> 3, j = e & 7;
        float pos = (float)(pi < 2048 ? pi : PAST + (pi - 2048));
        float inv = powf(500000.0f, -(float)j / 8.0f);
        float sn, cs;
        sincosf(pos * inv, &sn, &cs);
        ((float*)(WS(p) + W_ROPE))[e] = cs; ((float*)(WS(p) + W_ROPE))[2056 * 8 + e] = sn;
      }
      continue;
    }
    i -= N_ROPE;
    if (i < N_SC) {
      for (int e = tid; e < 16 * 1024; e += 256) {
        int r = i * 16 + (e >> 10), c = e & 1023;
        float v = 0.f;
        if (r < NB) v = silu_f(p.c_prompt[r * D + c]);
        else if (r < NROWS_C) v = silu_f(p.c_sample[(r - NB) * D + c]);
        ((u16*)(WS(p) + W_SC))[r * D + c] = f2bf(v);
      }
      continue;
    }
    i -= N_SC;
    if (i < N_TR) {
      float* tl = (float*)smem;
      if (i < 3072) { int l = i / 768, rem = i % 768; transpose_tile(tl, p.w_ada + (size_t)l * 1024 * 3072, 3072, ((u16*)(WS(p) + W_WT_ADA)) + (size_t)l * 3072 * LDA, LDA, rem / 48, rem % 48); }
      else if (i < 5376) { int j = i - 3072; int l = j / 576, rem = j % 576; transpose_tile(tl, p.w_in + (size_t)l * 1024 * 2304, 2304, ((u16*)(WS(p) + W_WT_IN)) + (size_t)l * 2304 * LDA, LDA, rem / 36, rem % 36); }
      else if (i < 5632) { int j = i - 5376; int l = j / 64, rem = j % 64; transpose_tile(tl, p.w_glu + (size_t)l * 512 * 512, 512, ((u16*)(WS(p) + W_WT_GLU)) + (size_t)l * 512 * LDH, LDH, rem / 8, rem % 8); }
      else { int j = i - 5632; int l = j / 256, rem = j % 256; transpose_tile(tl, p.w_out + (size_t)l * 1024 * 1024, 1024, ((u16*)(WS(p) + W_WT_OUT)) + (size_t)l * 1024 * LDA, LDA, rem / 16, rem % 16); }
      continue;
    }
    i -= N_TR;
    {
      int which = i >> 9, lb = i & 511;
      const float4* src = (const float4*)((which ? p.cache_v : p.cache_k) + (size_t)lb * 16384 + 8 * 128);
      float4* dst = (float4*)(OUTP(p) + (which ? O_VS : O_KS) + (size_t)lb * 16384);
      for (int e = tid; e < 3840; e += 256) dst[e] = src[e];
    }
  }
}
DI void phase_mod(const Params& p, char* smem) {
  constexpr int NT = 12288 / 128;
  for (int t = BID(); t < 2 * NT; t += gridDim.x) {
    int mt = t / NT, nt = t % NT;
    const int m0 = mt * 128, n0 = nt * 128;
    const u16* A = ((u16*)(WS(p) + W_SC));
    auto al = [&](int row, int k) { return *(const bf16x8*)(A + (size_t)row * D + k); };
    auto ep = [&](const float* Cs) {
      const int l = n0 / 3072, cb = n0 - l * 3072;
      float* md = ((float*)(WS(p) + W_MOD));
      for_chunks<128>([&](int row, int c8) {
        int r = m0 + row;
        if (r < NROWS_C) {
          float v[8], b[8];
          ld8(Cs + row * 132 + c8, v);
          ld8(p.b_ada + l * 3072 + cb + c8, b);
#pragma unroll
          for (int e = 0; e < 8; ++e) v[e] += b[e];
          st8(md + ((size_t)l * NROWS_C + r) * 3072 + cb + c8, v);
        }
      });
    };
    gemm_tile<4>((u16*)smem, m0, n0, 1024, al, ((u16*)(WS(p) + W_WT_ADA)), LDA, 1 << 30, 0, ep);
  }
}

DI void phase_norm(const Params& p, int l) {
  const int lane = TID() & 63, wid = TID() >> 6;
  const float* g = p.norm_g + l * D;
  for (int m = BID() * 4 + wid; m < NTOK; m += gridDim.x * 4) {
    const float* xr = (l == 0) ? xrow_in(p, m) : OUTP(p) + (size_t)m * D;
    const float* md = ((float*)(WS(p) + W_MOD)) + ((size_t)l * NROWS_C + brow_of(m)) * 3072;
    float4 v[4];
    float ss = 0.f;
#pragma unroll
    for (int i = 0; i < 4; ++i) {
      v[i] = *(const float4*)(xr + lane * 4 + 256 * i);
      ss += v[i].x * v[i].x + v[i].y * v[i].y + v[i].z * v[i].z + v[i].w * v[i].w;
    }
#pragma unroll
    for (int o = 32; o > 0; o >>= 1) ss += __shfl_xor(ss, o);
    float rstd = rsqrtf(ss * (1.f / D) + 1e-6f);
#pragma unroll
    for (int i = 0; i < 4; ++i) {
      int c = lane * 4 + 256 * i;
      float4 gg = *(const float4*)(g + c);
      float4 sh = *(const float4*)(md + c);
      float4 sc = *(const float4*)(md + 1024 + c);
      float a0 = v[i].x * rstd * gg.x * (1.f + sc.x) + sh.x;
      float a1 = v[i].y * rstd * gg.y * (1.f + sc.y) + sh.y;
      float a2 = v[i].z * rstd * gg.z * (1.f + sc.z) + sh.z;
      float a3 = v[i].w * rstd * gg.w * (1.f + sc.w) + sh.w;
      u32x2 o = {pack2(a0, a1), pack2(a2, a3)};
      *(u32x2*)(((u16*)(WS(p) + W_HN)) + (size_t)m * LDA + c) = o;
    }
  }
}
DI void phase_inproj(const Params& p, char* smem, int l, int vx, int vj) {
  constexpr int NT = INW / 128;
  constexpr int MT = NTOK / 128;
  const u16* Bt = ((u16*)(WS(p) + W_WT_IN)) + (size_t)l * INW * LDA;
  const int xcd = vx, nxb = gridDim.x >> 3;
  constexpr int PW = 9, MX = MT / 8;
  for (int i = vj; i < MX * NT; i += nxb) {
    int panel = i / (MX * PW), r = i - panel * (MX * PW);
    int mt = xcd * MX + r / PW, nt = panel * PW + r % PW;
    const int m0 = mt * 128, n0 = nt * 128;
    const u16* A = ((u16*)(WS(p) + W_HN));
    auto al = [&](int row, int k) { return *(const bf16x8*)(A + (size_t)row * LDA + k); };
    auto ep = [&](const float* Cs) {
      float* out = OUTP(p);
      if (nt < 5) {
        const float* rope = ((float*)(WS(p) + W_ROPE));
        u16* qd = ((u16*)(WS(p) + W_Q));
        u16* kd = ((u16*)(WS(p) + W_K));
        for_chunks<128>([&](int row, int c8) {
          const int m = m0 + row;
          const bool is_p = m < NTOK_P;
          int b, pos, ridx;
          if (is_p) { b = m >> 11; pos = m & 2047; ridx = pos; }
          else { int rr = m - NTOK_P; b = rr >> 3; pos = rr & 7; ridx = 2048 + pos; }
          float v[8];
          const float* c = Cs + row * 132 + c8;
          ld8(c, v);
          const int dd = c8 & 63;
          if (dd < 16) {
            float cs[8], sn[8], o[8];
            ld8(rope + ridx * 8, cs);
            ld8(rope + 2056 * 8 + ridx * 8, sn);
            if (dd == 0) { ld8(c + 8, o);
#pragma unroll
              for (int e = 0; e < 8; ++e) v[e] = v[e] * cs[e] - o[e] * sn[e];
            } else { ld8(c - 8, o);
#pragma unroll
              for (int e = 0; e < 8; ++e) v[e] = v[e] * cs[e] + o[e] * sn[e];
            }
          }
          if (nt < 4) st8bf(qd + (size_t)m * LDH + n0 + c8, v);
          else {
            st8bf(kd + (size_t)m * 128 + c8, v);
            if (is_p) { if (pos >= SEQ - 128) st8(out + O_KP + ((size_t)(l * NB + b) * 128 + (pos - (SEQ - 128))) * 128 + c8, v); }
            else st8(out + O_KS + ((size_t)(l * DB + b) * 128 + 120 + pos) * 128 + c8, v);
          }
        });
      } else if (nt == 5) {
        u16* vT = ((u16*)(WS(p) + W_VT));
        const int tid = TID();
#pragma unroll 2
        for (int it = 0; it < 8; ++it) {
          int idx = tid + 256 * it, col = idx & 127, rg = idx >> 7;
          const int m = m0 + rg * 8;
          float v[8];
#pragma unroll
          for (int e = 0; e < 8; ++e) v[e] = Cs[(rg * 8 + e) * 132 + col];
          if (m < NTOK_P) {
            int b = m >> 11, pos0 = m & 2047;
            st8bf(vT + ((size_t)(b * 128 + col)) * LDV + pos0, v);
            if (pos0 >= SEQ - 128) {
#pragma unroll
              for (int e = 0; e < 8; ++e) out[O_VP + ((size_t)(l * NB + b) * 128 + (pos0 + e - (SEQ - 128))) * 128 + col] = v[e];
            }
          } else {
            int b = (m - NTOK_P) >> 3;
            st8bf(vT + (size_t)NB * 128 * LDV + ((size_t)(b * 128 + col)) * 8, v);
#pragma unroll
            for (int e = 0; e < 8; ++e) out[O_VS + ((size_t)(l * DB + b) * 128 + 120 + e) * 128 + col] = v[e];
          }
        }
      } else {
        u16* dst; int cb;
        if (nt < 10) { dst = ((u16*)(WS(p) + W_ZA)); cb = n0 - 768; }
        else if (nt < 14) { dst = ((u16*)(WS(p) + W_U)); cb = n0 - 1280; }
        else { dst = ((u16*)(WS(p) + W_ZS)); cb = n0 - 1792; }
        const bool is_u = (nt >= 10) && (nt < 14);
        for_chunks<128>([&](int row, int c8) {
          float v[8];
          ld8(Cs + row * 132 + c8, v);
          const int c = cb + c8;
          if (is_u) st8bf(dst + ((size_t)(c >> 4) * NTOK + (m0 + row)) * 16 + (c & 15), v);
          else st8bf(dst + (size_t)(m0 + row) * LDH + c, v);
        });
      }
    };
    gemm_tile<4>((u16*)smem, m0, n0, 1024, al, Bt, LDA, 1 << 30, 0, ep);
  }
}

DI int crow(int i, int h) { return (i & 3) + 8 * (i >> 2) + 4 * h; }

template <bool SAMPLE>
DI void attn_task(const Params& p, int l, const u16* Ks, const u16* Vt, int VS, int koff, int kp0,
                  const u16* qptr, int qp, float sink, int tok_base, int head_base) {
  const int lane = TID() & 63, r = lane & 31, h = lane >> 5;
  bf16x8 qf[4];
#pragma unroll
  for (int s = 0; s < 4; ++s) qf[s] = *(const bf16x8*)(qptr + 16 * s + 8 * h);
  f32x16 sc[5];
#pragma unroll
  for (int t = 0; t < 5; ++t) {
    f32x16 acc;
#pragma unroll
    for (int i = 0; i < 16; ++i) acc[i] = 0.f;
#pragma unroll
    for (int s = 0; s < 4; ++s) {
      bf16x8 a = *(const bf16x8*)(Ks + (koff + t * 32 + r) * 72 + 16 * s + 8 * h);
      acc = __builtin_amdgcn_mfma_f32_32x32x16_bf16(a, qf[s], acc, 0, 0, 0);
    }
    sc[t] = acc;
  }
  float m = sink;
#pragma unroll
  for (int t = 0; t < 5; ++t)
#pragma unroll
    for (int i = 0; i < 16; ++i) {
      int kp = kp0 + koff + t * 32 + crow(i, h);
      int df = qp - kp;
      bool valid = (df >= 0) && (df <= 128) && (kp >= 0);
      float s = valid ? sc[t][i] * 0.125f : -1e30f;
      sc[t][i] = s;
      m = fmaxf(m, s);
    }
  m = fmaxf(m, __shfl_xor(m, 32));
  float lsum = 0.f;
#pragma unroll
  for (int t = 0; t < 5; ++t)
#pragma unroll
    for (int i = 0; i < 16; ++i) {
      float e = __expf(sc[t][i] - m);
      sc[t][i] = e;
      lsum += e;
    }
  lsum += __shfl_xor(lsum, 32);
  float inv = 1.f / (lsum + __expf(sink - m));
  f32x16 o[2];
#pragma unroll
  for (int i = 0; i < 16; ++i) { o[0][i] = 0.f; o[1][i] = 0.f; }
#pragma unroll
  for (int t = 0; t < 5; ++t)
#pragma unroll
    for (int s = 0; s < 2; ++s) {
      u32x4 pk;
#pragma unroll
      for (int e = 0; e < 4; ++e) pk[e] = pack2(sc[t][8 * s + 2 * e], sc[t][8 * s + 2 * e + 1]);
      bf16x8 pa = __builtin_bit_cast(bf16x8, pk);
      int kb = koff + t * 32 + 16 * s + 4 * h;
#pragma unroll
      for (int dt = 0; dt < 2; ++dt) {
        const u16* vp = Vt + (dt * 32 + r) * VS + kb;
        s16x4 lo = *(const s16x4*)vp;
        s16x4 hi = *(const s16x4*)(vp + 8);
        bf16x8 vb = __builtin_shufflevector(lo, hi, 0, 1, 2, 3, 4, 5, 6, 7);
        o[dt] = __builtin_amdgcn_mfma_f32_32x32x16_bf16(pa, vb, o[dt], 0, 0, 0);
      }
    }
  u16 zz[32];
#pragma unroll
  for (int i = 0; i < 16; ++i) {
    int row = crow(i, h);
    int tok, head;
    if (SAMPLE) { tok = tok_base + (row & 7); head = head_base + (row >> 3); }
    else { tok = tok_base + row; head = head_base; }
#pragma unroll
    for (int dt = 0; dt < 2; ++dt) zz[i * 2 + dt] = ((const u16*)(WS(p) + W_ZA))[(size_t)tok * LDH + head * 64 + dt * 32 + r];
  }
#pragma unroll
  for (int i = 0; i < 16; ++i) {
    int row = crow(i, h);
    float iq = __shfl(inv, row);
    int tok, head;
    if (SAMPLE) { tok = tok_base + (row & 7); head = head_base + (row >> 3); }
    else { tok = tok_base + row; head = head_base; }
#pragma unroll
    for (int dt = 0; dt < 2; ++dt) {
      int c = head * 64 + dt * 32 + r;
      float z = bf2f(zz[i * 2 + dt]);
      ((u16*)(WS(p) + W_MIX))[(size_t)tok * LDA + c] = f2bf(o[dt][i] * iq * silu_f(z));
    }
  }
}

DI void attn_prompt_item(const Params& p, char* smem, int l, int it) {
  const int tid = TID(), wid = tid >> 6, lane = tid & 63;
  const int b = it >> 6, h = (it >> 5) & 1, n = (it >> 1) & 15, half = it & 1;
  const int qb = n * 128 + half * 64, kstart = qb - 128;
  u16* Ks = (u16*)smem;
  u16* Vt = Ks + 192 * 72;
  for (int idx = tid; idx < 192 * 8; idx += 256) {
    int key = idx >> 3, ch = idx & 7, pos = kstart + key;
    bf16x8 v = {0, 0, 0, 0, 0, 0, 0, 0};
    if (pos >= 0) v = *(const bf16x8*)(((u16*)(WS(p) + W_K)) + ((size_t)(b * SEQ + pos)) * 128 + h * 64 + ch * 8);
    *(bf16x8*)(Ks + key * 72 + ch * 8) = v;
  }
  for (int idx = tid; idx < 64 * 24; idx += 256) {
    int d = idx / 24, ch = idx - d * 24, pos0 = kstart + ch * 8;
    s16x4 lo = {0, 0, 0, 0}, hi = {0, 0, 0, 0};
    if (pos0 >= 0) {
      const u16* src = ((u16*)(WS(p) + W_VT)) + ((size_t)((b * 2 + h) * 64 + d)) * LDV + pos0;
      lo = *(const s16x4*)src; hi = *(const s16x4*)(src + 4);
    }
    *(s16x4*)(Vt + d * 196 + ch * 8) = lo;
    *(s16x4*)(Vt + d * 196 + ch * 8 + 4) = hi;
  }
  __syncthreads();
  const int head = h * 4 + wid;
  const float sink = p.sinks[l * 8 + head];
#pragma unroll 1
  for (int r = 0; r < 2; ++r) {
    int q0 = qb + r * 32;
    const u16* qptr = ((u16*)(WS(p) + W_Q)) + ((size_t)(b * SEQ + q0 + (lane & 31))) * LDH + head * 64;
    attn_task<false>(p, l, Ks, Vt, 196, r * 32, kstart, qptr, q0 + (lane & 31), sink, b * SEQ + q0, head);
  }
  __syncthreads();
}

DI void attn_sample_item(const Params& p, char* smem, int l, int it) {
  const int tid = TID(), wid = tid >> 6, lane = tid & 63;
  const int b = it >> 1, h = it & 1;
  u16* Ks = (u16*)smem;
  u16* Vt = Ks + 160 * 72;
  const float* ck = p.cache_k + ((size_t)(l * DB + b)) * 16384 + h * 64;
  const float* cv = p.cache_v + ((size_t)(l * DB + b)) * 16384 + h * 64;
  for (int idx = tid; idx < 160 * 16; idx += 256) {
    int key = idx >> 4, c4 = (idx & 15) * 4;
    u32x2 o = {0u, 0u};
    if (key < 128) {
      float4 v = *(const float4*)(ck + (size_t)key * 128 + c4);
      o[0] = pack2(v.x, v.y); o[1] = pack2(v.z, v.w);
    } else if (key < 136) {
      o = *(const u32x2*)(((u16*)(WS(p) + W_K)) + ((size_t)(NTOK_P + b * 8 + key - 128)) * 128 + h * 64 + c4);
    }
    *(u32x2*)(Ks + key * 72 + c4) = o;
  }
  for (int idx = tid; idx < 128 * 16; idx += 256) {
    int key = idx >> 4, c4 = (idx & 15) * 4;
    float4 v = *(const float4*)(cv + (size_t)key * 128 + c4);
    Vt[(c4 + 0) * 164 + key] = f2bf(v.x);
    Vt[(c4 + 1) * 164 + key] = f2bf(v.y);
    Vt[(c4 + 2) * 164 + key] = f2bf(v.z);
    Vt[(c4 + 3) * 164 + key] = f2bf(v.w);
  }
  if (tid < 64) {
    int d = tid;
    const u16* src = ((u16*)(WS(p) + W_VT)) + (size_t)NB * 128 * LDV + ((size_t)((b * 2 + h) * 64 + d)) * 8;
    s16x4 lo = *(const s16x4*)src, hi = *(const s16x4*)(src + 4);
    s16x4 z = {0, 0, 0, 0};
    u16* dst = Vt + d * 164 + 128;
    *(s16x4*)dst = lo; *(s16x4*)(dst + 4) = hi;
#pragma unroll
    for (int e = 2; e < 8; ++e) *(s16x4*)(dst + 4 * e) = z;
  }
  __syncthreads();
  if (wid == 0) {
    int r = lane & 31, g = r >> 3, t = r & 7;
    const u16* qptr = ((u16*)(WS(p) + W_Q)) + ((size_t)(NTOK_P + b * 8 + t)) * LDH + (h * 4 + g) * 64;
    float sink = p.sinks[l * 8 + h * 4 + g];
    attn_task<true>(p, l, Ks, Vt, 164, 0, PAST - 128, qptr, PAST + t, sink, NTOK_P + b * 8, h * 4);
  }
  __syncthreads();
}
DI void ssm_g1_tile(const Params& p, char* smem, int l, int it) {
  const bool smp = it >= 256;
  const int g = smp ? it - 256 : (it & 31);
  const int mt = smp ? 0 : (it >> 5);
  const u16* U = ((u16*)(WS(p) + W_U));
  auto al = [&](int row, int k) {
    int tok = smp ? (NTOK_P + row * 8 + (k >> 4)) : (row * 16 + (k >> 4));
    return *(const bf16x8*)(U + ((size_t)g * NTOK + tok) * 16 + (k & 15));
  };
  const float* ap = ((float*)(WS(p) + W_APOW)) + (size_t)(l * 32 + g) * 256;
  auto ep = [&](const float* Csc) {
    float* Cs = const_cast<float*>(Csc);
    float* out = OUTP(p);
    const int tid = TID();
    if (smp) {
      u16* cr = ((u16*)(WS(p) + W_CARRY_S));
      for_chunks<128>([&](int row, int c8) {
        const int b = row, pp = c8 & 63;
        const bool im = c8 >= 64;
        float s[8], hr[8], hi[8], ar[8], ai[8], o[8];
        ld8(Cs + row * 132 + c8, s);
        size_t si = ((size_t)(l * DB + b) * 32 + g) * 64 + pp;
        ld8(p.st_re + si, hr); ld8(p.st_im + si, hi);
        ld8(ap + 128 + pp, ar); ld8(ap + 192 + pp, ai);
#pragma unroll
        for (int e = 0; e < 8; ++e) o[e] = im ? (ar[e] * hi[e] + ai[e] * hr[e] + s[e]) : (ar[e] * hr[e] - ai[e] * hi[e] + s[e]);
        st8(out + (im ? O_SIS : O_SRS) + si, o);
        st8bf(cr + ((size_t)g * DB + b) * 128 + c8, im ? hi : hr);
      });
    } else {
      const int b = mt;
      const int pp = tid & 63, sg = tid >> 6;
      const float ar = ap[pp], ai = ap[64 + pp];
      float hr = 0.f, hi = 0.f;
#pragma unroll 4
      for (int j = sg * 32; j < sg * 32 + 32; ++j) {
        float sr = Cs[j * 132 + pp], si = Cs[j * 132 + 64 + pp];
        float nr = ar * hr - ai * hi + sr, ni = ar * hi + ai * hr + si;
        hr = nr; hi = ni;
      }
      float pr = ar, pi = ai;
#pragma unroll
      for (int q = 0; q < 5; ++q) { float t = pr * pr - pi * pi; pi = 2.f * pr * pi; pr = t; }
      float* Ls = Cs + 128 * 132;
      Ls[sg * 128 + pp] = hr; Ls[sg * 128 + 64 + pp] = hi;
      __syncthreads();
      float cr_ = 0.f, ci_ = 0.f;
      for (int s2 = 0; s2 < sg; ++s2) {
        float lr = Ls[s2 * 128 + pp], li = Ls[s2 * 128 + 64 + pp];
        float nr = pr * cr_ - pi * ci_ + lr, ni = pr * ci_ + pi * cr_ + li;
        cr_ = nr; ci_ = ni;
      }
      hr = cr_; hi = ci_;
#pragma unroll 4
      for (int j = sg * 32; j < sg * 32 + 32; ++j) {
        float sr = Cs[j * 132 + pp], si = Cs[j * 132 + 64 + pp];
        Cs[j * 132 + pp] = hr; Cs[j * 132 + 64 + pp] = hi;
        float nr = ar * hr - ai * hi + sr, ni = ar * hi + ai * hr + si;
        hr = nr; hi = ni;
      }
      if (sg == 3) {
        out[O_SRP + ((size_t)(l * NB + b) * 32 + g) * 64 + pp] = hr;
        out[O_SIP + ((size_t)(l * NB + b) * 32 + g) * 64 + pp] = hi;
      }
      __syncthreads();
      u16* cr = ((u16*)(WS(p) + W_CARRY_P));
      for_chunks<128>([&](int row, int c8) {
        float v[8];
        ld8(Cs + row * 132 + c8, v);
        st8bf(cr + ((size_t)g * NCH_P + (b * 128 + row)) * 128 + c8, v);
      });
    }
  };
  const u16* Bt = ((u16*)(WS(p) + W_BT1)) + (size_t)(l * 32 + g) * 128 * LDB1 + (smp ? 128 : 0);
  gemm_tile<4>((u16*)smem, mt * 128, 0, smp ? 128 : 256, al, Bt, LDB1, 1 << 30, 0, ep);
}

DI void ssm_y_tile(const Params& p, char* smem, int l, int it) {
  {
    const bool smp = it >= 512;
    int g, mt, nt;
    if (smp) { g = it - 512; mt = 0; nt = 0; }
    else { g = it & 31; nt = (it >> 5) & 1; mt = it >> 6; }
    const int KU = (smp || nt == 0) ? 128 : 256;
    const int m0 = mt * 128, n0 = nt * 128;
    const u16* U = ((u16*)(WS(p) + W_U));
    const u16* CR = smp ? ((u16*)(WS(p) + W_CARRY_S)) : ((u16*)(WS(p) + W_CARRY_P));
    auto al = [&](int row, int k) {
      if (k < KU) {
        int tok = smp ? (NTOK_P + row * 8 + (k >> 4)) : (row * 16 + (k >> 4));
        return *(const bf16x8*)(U + ((size_t)g * NTOK + tok) * 16 + (k & 15));
      } else {
        return *(const bf16x8*)(CR + ((size_t)g * (smp ? DB : NCH_P) + row) * 128 + (k - KU));
      }
    };
    auto ep = [&](const float* Cs) {
      u16* yg = ((u16*)(WS(p) + W_YG));
      for_chunks<128>([&](int row, int c8) {
        int col = n0 + c8, t = col >> 4, c0 = col & 15;
        int tok = smp ? (NTOK_P + (m0 + row) * 8 + t) : ((m0 + row) * 16 + t);
        float v[8];
        ld8(Cs + row * 132 + c8, v);
#pragma unroll
        for (int e = 0; e < 8; ++e) v[e] = gelu_tanh(v[e]);
        st8bf_wt(yg + (size_t)tok * LDH + g * 16 + c0, v);
      });
    };
    const u16* Bt = ((u16*)(WS(p) + W_BT2)) + (size_t)(l * 32 + g) * 256 * LDB2;
    gemm_tile<4>((u16*)smem, m0, n0, KU + 128, al, Bt, LDB2, KU, 256 - KU, ep);
  }
}

template <int MI>
DI void glu_tile(const Params& p, char* smem, int l, int m0, int n0) {
  constexpr int BM = 32 * MI;
  const u16* Bt = ((u16*)(WS(p) + W_WT_GLU)) + (size_t)l * 512 * LDH;
  const u16* A = ((u16*)(WS(p) + W_YG));
  auto al = [&](int row, int k) { return *(const bf16x8*)(A + (size_t)row * LDH + k); };
  auto ep = [&](const float* Cs) {
    const u16* yg = ((u16*)(WS(p) + W_YG));
    const u16* zs = ((u16*)(WS(p) + W_ZS));
    u16* mix = ((u16*)(WS(p) + W_MIX));
    for_chunks<BM>([&](int row, int c8) {
      const int m = m0 + row, col = n0 + c8;
      float v[8], y[8], z[8], bg[8];
      ld8(Cs + row * 132 + c8, v);
      ld8bf(yg + (size_t)m * LDH + col, y);
      ld8bf(zs + (size_t)m * LDH + col, z);
      ld8(p.b_glu + l * 512 + col, bg);
#pragma unroll
      for (int e = 0; e < 8; ++e) v[e] = y[e] * sigmoid_f(v[e] + bg[e]) * silu_f(z[e]);
      st8bf(mix + (size_t)m * LDA + 512 + col, v);
    });
  };
  gemm_tile<MI>((u16*)smem, m0, n0, 512, al, Bt, LDH, 1 << 30, 0, ep);
}
DI void chain_done(unsigned* cnt) {
  asm volatile("s_waitcnt vmcnt(0)" ::: "memory");
  __syncthreads();
  (void)__hip_atomic_fetch_add(cnt, 1u, __ATOMIC_RELAXED, __HIP_MEMORY_SCOPE_AGENT);
}
DI void wait_chains(unsigned* cnt, unsigned need) {
  unsigned sp = 0;
  for (;;) {
    const unsigned v = (unsigned)__builtin_amdgcn_readfirstlane((int)__hip_atomic_load(cnt, __ATOMIC_RELAXED, __HIP_MEMORY_SCOPE_AGENT));
    if (v >= need) break;
    __builtin_amdgcn_s_sleep(8);
    if (++sp > (1u << 14)) break;
  }
  __builtin_amdgcn_fence(__ATOMIC_ACQUIRE, "agent");
  asm volatile("s_waitcnt vmcnt(0)" ::: "memory");
  __syncthreads();
}

DI void phase_attn(const Params& p, char* smem, int l, int* q_slot) {
  unsigned* base = (unsigned*)(WS(p) + W_QUEUE) + (size_t)l * 16 * 64;
  for (;;) {
    if (threadIdx.x == 0) *q_slot = (int)atomicAdd(base, 1u);
    __syncthreads();
    const int it = __builtin_amdgcn_readfirstlane(*q_slot);
    __syncthreads();
    if (it >= 1696) break;
    if (it < 256) {
      const int b = it >> 5, g = it & 31;
      ssm_g1_tile(p, smem, l, it);
      __threadfence_block();
      asm volatile("s_waitcnt vmcnt(0)" ::: "memory");
      __syncthreads();
      ssm_y_tile(p, smem, l, b * 64 + g);
      ssm_y_tile(p, smem, l, b * 64 + 32 + g);
      chain_done(base + (1 + b) * 64);
    } else if (it < 288) {
      ssm_g1_tile(p, smem, l, it);
      __threadfence_block();
      asm volatile("s_waitcnt vmcnt(0)" ::: "memory");
      __syncthreads();
      ssm_y_tile(p, smem, l, 512 + (it - 256));
      chain_done(base + 9 * 64);
    } else if (it < 800) {
      attn_prompt_item(p, smem, l, it - 288);
    } else if (it < 1056) {
      attn_sample_item(p, smem, l, it - 800);
    } else if (it < 1568) {
      const int t = it - 1056, mt = t >> 2, nt = t & 3;
      wait_chains(base + (1 + (mt >> 4)) * 64, 32u * 256u);
      glu_tile<4>(p, smem, l, mt * 128, nt * 128);
    } else {
      const int t = it - 1568, mt = t >> 2, nt = t & 3;
      wait_chains(base + 9 * 64, 32u * 256u);
      glu_tile<1>(p, smem, l, NTOK_P + mt * 32, nt * 128);
    }
  }
}

template <int MI>
DI void outproj_tile(const Params& p, char* smem, int l, int m0, int n0) {
  constexpr int BM = 32 * MI;
  const u16* Bt = ((u16*)(WS(p) + W_WT_OUT)) + (size_t)l * 1024 * LDA;
  const u16* A = ((u16*)(WS(p) + W_MIX));
  auto al = [&](int row, int k) { return *(const bf16x8*)(A + (size_t)row * LDA + k); };
  auto ep = [&](const float* Cs) {
    float* out = OUTP(p);
    const float* md = ((float*)(WS(p) + W_MOD));
    for_chunks<BM>([&](int row, int c8) {
      const int m = m0 + row, col = n0 + c8;
      float v[8], gt[8], xo[8];
      ld8(Cs + row * 132 + c8, v);
      ld8(md + ((size_t)l * NROWS_C + brow_of(m)) * 3072 + 2048 + col, gt);
      ld8((l == 0) ? xrow_in(p, m) + col : out + (size_t)m * D + col, xo);
#pragma unroll
      for (int e = 0; e < 8; ++e) v[e] = xo[e] + gt[e] * v[e];
      st8(out + (size_t)m * D + col, v);
    });
  };
  gemm_tile<MI>((u16*)smem, m0, n0, 1024, al, Bt, LDA, 1 << 30, 0, ep);
}
DI void phase_outproj(const Params& p, char* smem, int l, int vx, int vj) {
  const int xcd = vx, nxb = gridDim.x >> 3;
  for (int i = vj; i < 16 * 8; i += nxb) outproj_tile<4>(p, smem, l, (xcd * 16 + i / 8) * 128, (i % 8) * 128);
  for (int i = vj; i < 4 * 8; i += nxb) outproj_tile<1>(p, smem, l, NTOK_P + (xcd * 4 + i / 8) * 32, (i % 8) * 128);
}

DI void phase_final(const Params& p) {
  const int lane = TID() & 63, wid = TID() >> 6;
  for (int m = BID() * 4 + wid; m < NTOK; m += gridDim.x * 4) {
    float* xr = OUTP(p) + (size_t)m * D;
    float4 v[4];
    float ss = 0.f;
#pragma unroll
    for (int i = 0; i < 4; ++i) {
      v[i] = *(const float4*)(xr + lane * 4 + 256 * i);
      ss += v[i].x * v[i].x + v[i].y * v[i].y + v[i].z * v[i].z + v[i].w * v[i].w;
    }
#pragma unroll
    for (int o = 32; o > 0; o >>= 1) ss += __shfl_xor(ss, o);
    float rstd = rsqrtf(ss * (1.f / D) + 1e-6f);
#pragma unroll
    for (int i = 0; i < 4; ++i) {
      int c = lane * 4 + 256 * i;
      float4 gg = *(const float4*)(p.final_g + c);
      float4 o = {v[i].x * rstd * gg.x, v[i].y * rstd * gg.y, v[i].z * rstd * gg.z, v[i].w * rstd * gg.w};
      *(float4*)(xr + c) = o;
    }
  }
}

#define XB_TMO      128
#define XB_XCNT(j)  (256  + 64 * (j))
#define XB_XSUB(j)  (1280 + 64 * (j))
#define XB_XGEN(j)  (2304 + 64 * (j))
#define XB_TOP      3328
#define XB_TOPGEN   3392
#define XCD_BAR_WORDS 3456
#define XB_SPIN_CAP (1u << 18)
#define LAS __attribute__((address_space(3)))
DI unsigned xb_ld(unsigned* p)              { return __hip_atomic_load(p, __ATOMIC_RELAXED, __HIP_MEMORY_SCOPE_AGENT); }
DI unsigned xb_add(unsigned* p, unsigned v) { return __hip_atomic_fetch_add(p, v, __ATOMIC_RELAXED, __HIP_MEMORY_SCOPE_AGENT); }
DI unsigned xb_xcc_id() { return (unsigned)__builtin_amdgcn_s_getreg((3 << 11) | 20) & 0xFu; }
#define XB_SPIN(cond, bar) do { unsigned _sp = 0; while (cond) { __builtin_amdgcn_s_sleep(1); \
    if ((++_sp & 255u) == 0u) { if (xb_ld(&(bar)[XB_TMO])) break; if (_sp > XB_SPIN_CAP) { atomicAdd(&(bar)[XB_TMO], 1u); break; } } } } while (0)
struct XcdBarrier { unsigned* bar; unsigned x; volatile LAS unsigned* st; };
DI XcdBarrier xcd_barrier_post(unsigned* bar, volatile LAS unsigned* st) {
  XcdBarrier b; b.bar = bar; b.x = xb_xcc_id(); b.st = st;
  if (threadIdx.x == 0) st[2] = xb_add(&bar[XB_XCNT(b.x)], 1u);
  return b;
}
DI void xcd_barrier_complete(unsigned* bar, unsigned x, unsigned& nloc, unsigned& nx, unsigned& bal) {
  const unsigned G = gridDim.x * gridDim.y * gridDim.z;
  unsigned sum, cnt, mine, sp = 0u, even;
  for (;;) {
    sum = 0u; cnt = 0u; mine = 0u; even = 1u;
#pragma unroll
    for (unsigned j = 0; j < 16; ++j) { const unsigned c = xb_ld(&bar[XB_XCNT(j)]); sum += c; cnt += (c > 0u) ? 1u : 0u; mine = (j == x) ? c : mine;
      if (c != ((j < 8u) ? (G >> 3) : 0u)) even = 0u; }
    if (sum == G) break;
    __builtin_amdgcn_s_sleep(1);
    if ((++sp & 255u) == 0u) { if (xb_ld(&bar[XB_TMO])) break; if (sp > XB_SPIN_CAP) { atomicAdd(&bar[XB_TMO], 1u); break; } }
  }
  nloc = mine > 0u ? mine : 1u; nx = cnt > 0u ? cnt : 1u;
  bal = (sum == G && even) ? 2u : 1u;
}
DI void xcd_barrier(const XcdBarrier& b) {
  asm volatile("s_waitcnt vmcnt(0)" ::: "memory");
  __syncthreads();
  if (threadIdx.x == 0) {
    unsigned* bar = b.bar;
    __builtin_amdgcn_s_waitcnt(0);
    unsigned nloc = b.st[0], nx = b.st[1];
    if (nloc == 0u) { unsigned bal; xcd_barrier_complete(bar, b.x, nloc, nx, bal); b.st[0] = nloc; b.st[1] = nx; b.st[3] = bal; }
    const unsigned old = xb_add(&bar[XB_XSUB(b.x)], 1u);
    const unsigned gen = old / nloc;
    if (old + 1u == (gen + 1u) * nloc) {
      __builtin_amdgcn_fence(__ATOMIC_RELEASE, "agent");
      asm volatile("s_waitcnt vmcnt(0)" ::: "memory");
      const unsigned og = xb_add(&bar[XB_TOP], 1u);
      const unsigned tg = og / nx;
      if (og + 1u == (tg + 1u) * nx) xb_add(&bar[XB_TOPGEN], 1u);
      else XB_SPIN(xb_ld(&bar[XB_TOPGEN]) == tg, bar);
      __builtin_amdgcn_fence(__ATOMIC_ACQUIRE, "agent");
      xb_add(&bar[XB_XGEN(b.x)], 1u);
      asm volatile("s_waitcnt vmcnt(0)" ::: "memory");
    } else {
      XB_SPIN(xb_ld(&bar[XB_XGEN(b.x)]) == gen, bar);
      __builtin_amdgcn_fence(__ATOMIC_ACQUIRE, "agent");
      asm volatile("s_waitcnt vmcnt(0)" ::: "memory");
    }
  }
  __syncthreads();
}
constexpr int N_PHASES = 2 + 4 * DEPTH + 1;

__global__ void __launch_bounds__(256, 2) fwd_kernel(Params p) {
  __shared__ __attribute__((aligned(16))) char smem[73728];
  __shared__ uint4 xb_words;
  __shared__ int q_slot;
  cg::grid_group grid = cg::this_grid();
  if (threadIdx.x == 0) xb_words = make_uint4(0u, 0u, 0u, 0u);
  __syncthreads();
  XcdBarrier xb = xcd_barrier_post((unsigned*)(p.ws + W_BAR), (volatile LAS unsigned*)&xb_words);
  if (p.phase_lo < 0) grid.sync();
  for (int ph = p.phase_lo; ph < p.phase_hi; ++ph) {
    int vx = BID() & 7, vj = BID() >> 3;
    if (USE_XCC_MAP && xb.st[3] == 2u) { vx = (int)xb.x; vj = (int)xb.st[2]; }
    vx = __builtin_amdgcn_readfirstlane(vx); vj = __builtin_amdgcn_readfirstlane(vj);
    if (ph == 0) { for (int r = 0; r < REP_PREP; ++r) phase_prep(p, smem); }
    else if (ph == 1) { for (int r = 0; r < REP_MOD; ++r) phase_mod(p, smem); }
    else if (ph == N_PHASES - 1) phase_final(p);
    else {
      int l = (ph - 2) / 4, s = (ph - 2) % 4;
      switch (s) {
        case 0: for (int r = 0; r < REP_NORM; ++r) phase_norm(p, l); break;
        case 1: for (int r = 0; r < REP_INPROJ; ++r) phase_inproj(p, smem, l, vx, vj); break;
        case 2: phase_attn(p, smem, l, &q_slot); break;
        default: phase_outproj(p, smem, l, vx, vj); break;
      }
    }
    if (ph + 1 < p.phase_hi) xcd_barrier(xb);
  }
}

extern "C" void kernel_launch(void* const* d_in, const int* in_sizes, int n_in, void* d_out, int out_size,
                              void* d_ws, size_t ws_size, hipStream_t stream) {
  static int grid_blocks = 0;
  if (!grid_blocks) {
    int dev = 0, cus = 0, per_cu = 0;
    hipGetDevice(&dev);
    hipDeviceGetAttribute(&cus, hipDeviceAttributeMultiprocessorCount, dev);
    hipOccupancyMaxActiveBlocksPerMultiprocessor(&per_cu, fwd_kernel, 256, 0);
    if (per_cu > 2) per_cu = 2;
    if (per_cu < 1) per_cu = 1;
    grid_blocks = cus * per_cu;
  }
  Params p{};
  const float** fp = (const float**)&p;
  for (int i = 0; i < 25; ++i) fp[i] = (const float*)d_in[i];
  p.out = (float*)d_out;
  p.ws = (char*)d_ws;
  if (W_TOTAL > ws_size) fprintf(stderr, "workspace too small: need %zu have %zu\n", (size_t)W_TOTAL, ws_size);
  hipMemsetAsync((char*)d_ws + W_BAR, 0, (size_t)(3456 + 4 * 16 * 64) * 4, stream);
  p.phase_lo = 0; p.phase_hi = N_PHASES;
  void* args[] = {&p};
  hipError_t e = hipLaunchCooperativeKernel((void*)fwd_kernel, dim3(grid_blocks), dim3(256), args, 0, stream);
  if (e != hipSuccess) fprintf(stderr, "cooperative launch failed: %s (grid %d)\n", hipGetErrorString(e), grid_blocks);
}
```

```cpp
#include <hip/hip_runtime.h>
#include <hip/hip_cooperative_groups.h>
#include <cstdio>
namespace cg = cooperative_groups;


#define USE_XCC_MAP 0
#define REP_PREP 1
#define REP_MOD 1
#define REP_NORM 1
#define REP_INPROJ 1
#define REP_ATTN 1
#define REP_GLU 1
#define REP_OUT0 1
typedef unsigned short u16;
using bf16x8 = __attribute__((ext_vector_type(8))) short;
using s16x4  = __attribute__((ext_vector_type(4))) short;
using f32x4  = __attribute__((ext_vector_type(4))) float;
using f32x16 = __attribute__((ext_vector_type(16))) float;
using u32x2  = __attribute__((ext_vector_type(2))) unsigned;
using u32x4  = __attribute__((ext_vector_type(4))) unsigned;
typedef __bf16 bf16_2 __attribute__((ext_vector_type(2)));
typedef float float_2 __attribute__((ext_vector_type(2)));
#define DI __device__ __forceinline__

constexpr int D = 1024, NB = 8, SEQ = 2048, DEPTH = 4, DB = 128, DS = 8;
constexpr int NTOK_P = NB * SEQ;
constexpr int NTOK = NTOK_P + DB * DS;
constexpr int INW = 2304;
constexpr int NROWS_C = NB + DB;
constexpr int PAST = 8192;
constexpr int TCH = 16;
constexpr int NCH_P = NTOK_P / TCH;
constexpr size_t O_KP = 17825792, O_VP = 18350080, O_SRP = 18874368, O_SIP = 18939904,
                 O_KS = 19005440, O_VS = 27394048, O_SRS = 35782656, O_SIS = 36831232;

struct Params {
  const float *x_prompt, *x_sample, *cache_k, *cache_v, *st_re, *st_im, *c_prompt, *c_sample,
      *norm_g, *w_ada, *b_ada, *w_in, *sinks, *a_re, *a_im, *log_dt, *b_re, *b_im, *c_re, *c_im,
      *ssm_d, *w_glu, *b_glu, *w_out, *final_g;
  float* out;
  char* ws;
  int phase_lo, phase_hi;
};
constexpr size_t al256(size_t x) { return (x + 255) & ~(size_t)255; }
constexpr int LDA = 1088;
constexpr int LDH = 576;
constexpr int LDV = 2112;
constexpr int LDB1 = 320;
constexpr int LDB2 = 448;
constexpr size_t W_WT_IN = 0;
constexpr size_t W_WT_GLU = W_WT_IN + al256((size_t)4 * 2304 * LDA * 2);
constexpr size_t W_WT_OUT = W_WT_GLU + al256((size_t)4 * 512 * LDH * 2);
constexpr size_t W_SC = W_WT_OUT + al256((size_t)4 * 1024 * LDA * 2);
constexpr size_t W_MOD = W_SC + al256((size_t)256 * 1024 * 2);
constexpr size_t W_MIX = W_MOD + al256((size_t)4 * NROWS_C * 3072 * 4);
constexpr size_t W_HN = W_MIX;
constexpr size_t W_WT_ADA = W_MIX;
constexpr size_t W_Q = W_MIX + al256((size_t)NTOK * LDA * 2);
constexpr size_t W_YG = W_Q + al256((size_t)NTOK * LDH * 2);
constexpr size_t W_K = W_YG + al256((size_t)NTOK * LDH * 2);
constexpr size_t W_VT = W_K + al256((size_t)NTOK * 128 * 2);
constexpr size_t W_ZA = W_VT + al256(((size_t)NB * 128 * LDV + (size_t)DB * 128 * 8) * 2);
constexpr size_t W_U = W_ZA + al256((size_t)NTOK * LDH * 2);
constexpr size_t W_ZS = W_U + al256((size_t)NTOK * LDH * 2);
constexpr size_t W_BT1 = W_ZS + al256((size_t)NTOK * LDH * 2);
constexpr size_t W_BT2 = W_BT1 + al256((size_t)128 * 128 * LDB1 * 2);
constexpr size_t W_APOW = W_BT2 + al256((size_t)128 * 256 * LDB2 * 2);
constexpr size_t W_CARRY_P = W_APOW + al256((size_t)128 * 256 * 4);
constexpr size_t W_CARRY_S = W_CARRY_P + al256((size_t)NCH_P * 32 * 128 * 2);
constexpr size_t W_ROPE = W_CARRY_S + al256((size_t)DB * 32 * 128 * 2);
constexpr size_t W_BAR = W_ROPE + al256((size_t)2 * 2056 * 8 * 4);
constexpr size_t W_QUEUE = W_BAR + (size_t)3456 * 4;
constexpr size_t W_MODCNT = W_QUEUE + (size_t)4 * 16 * 64 * 4;
constexpr size_t W_TOTAL = W_BAR + al256((size_t)(3456 + 4 * 16 * 64 + 96 * 16) * 4);


DI int TID() { int t = threadIdx.x; asm volatile("" : "+v"(t)); return t; }
DI int BID() { int b = blockIdx.x; asm volatile("" : "+s"(b)); return b; }
DI char* WS(const Params& p) { size_t z = 0; asm volatile("" : "+s"(z)); return p.ws + z; }
DI float* OUTP(const Params& p) { size_t z = 0; asm volatile("" : "+s"(z)); return p.out + z; }

DI unsigned pack2(float a, float b) {
  float_2 f = {a, b};
  bf16_2 r = __builtin_convertvector(f, bf16_2);
  return __builtin_bit_cast(unsigned, r);
}
DI u16 f2bf(float a) { return (u16)(pack2(a, 0.f) & 0xffffu); }
DI float bf2f(u16 v) { return __uint_as_float(((unsigned)v) << 16); }
DI float silu_f(float x) { return x / (1.f + __expf(-x)); }
DI float sigmoid_f(float x) { return 1.f / (1.f + __expf(-x)); }
DI float gelu_tanh(float x) {
  float u = 0.7978845608028654f * (x + 0.044715f * x * x * x);
  return x / (1.f + __expf(-2.f * u));
}
DI const float* xrow_in(const Params& p, int m) {
  return m < NTOK_P ? p.x_prompt + (size_t)m * D : p.x_sample + (size_t)(m - NTOK_P) * D;
}
DI int brow_of(int m) { return m < NTOK_P ? (m >> 11) : NB + ((m - NTOK_P) >> 3); }
template <int MI, class AL, class EP>
DI void gemm_tile(u16* sm, int m0, int n0, int K, AL al, const u16* __restrict__ Bt, int ldb,
                  int bskip_at, int bskip, EP ep) {
  constexpr int BM = 32 * MI;
  u16* As = sm;
  u16* Bs = sm + 2 * BM * 72;
  const int tid = TID(), lane = tid & 63, wid = tid >> 6;
  const int wr = wid >> 1, wc = wid & 1, fr = lane & 15, fq = lane >> 4;
  const int lrow = tid >> 3, lk = (tid & 7) * 8;
  f32x4 acc[MI][4];
#pragma unroll
  for (int m = 0; m < MI; ++m)
#pragma unroll
    for (int n = 0; n < 4; ++n) acc[m][n] = f32x4{0.f, 0.f, 0.f, 0.f};
  bf16x8 pa0[MI], pb0[4], pa1[MI], pb1[4];
  const int nk = K >> 6;
  auto gload = [&](bf16x8* pa, bf16x8* pb, int kt) {
    int k = kt * 64 + lk;
    int kb = k + (k >= bskip_at ? bskip : 0);
#pragma unroll
    for (int i = 0; i < MI; ++i) pa[i] = al(m0 + lrow + 32 * i, k);
#pragma unroll
    for (int i = 0; i < 4; ++i) pb[i] = *(const bf16x8*)(Bt + (size_t)(n0 + lrow + 32 * i) * ldb + kb);
  };
  auto lstore = [&](const bf16x8* pa, const bf16x8* pb, int buf) {
#pragma unroll
    for (int i = 0; i < MI; ++i) *(bf16x8*)(As + buf * BM * 72 + (lrow + 32 * i) * 72 + lk) = pa[i];
#pragma unroll
    for (int i = 0; i < 4; ++i) *(bf16x8*)(Bs + buf * 9216 + (lrow + 32 * i) * 72 + lk) = pb[i];
  };
  auto compute = [&](int cur) {
    const u16* Ac = As + cur * BM * 72 + (wr * MI * 16 + fr) * 72 + fq * 8;
    const u16* Bc = Bs + cur * 9216 + (wc * 64 + fr) * 72 + fq * 8;
    bf16x8 af[2][MI], bv[2][4];
#pragma unroll
    for (int kk = 0; kk < 2; ++kk) {
#pragma unroll
      for (int n = 0; n < 4; ++n) bv[kk][n] = *(const bf16x8*)(Bc + n * 16 * 72 + kk * 32);
#pragma unroll
      for (int m = 0; m < MI; ++m) af[kk][m] = *(const bf16x8*)(Ac + m * 16 * 72 + kk * 32);
    }
    __builtin_amdgcn_sched_barrier(0);
#pragma unroll
    for (int kk = 0; kk < 2; ++kk)
#pragma unroll
      for (int m = 0; m < MI; ++m)
#pragma unroll
        for (int n = 0; n < 4; ++n)
          acc[m][n] = __builtin_amdgcn_mfma_f32_16x16x32_bf16(af[kk][m], bv[kk][n], acc[m][n], 0, 0, 0);
    __builtin_amdgcn_sched_barrier(0);
  };
  gload(pa0, pb0, 0);
  gload(pa1, pb1, 1);
  lstore(pa0, pb0, 0);
  __syncthreads();
  int kt = 0;
  for (; kt + 2 < nk; kt += 2) {
    gload(pa0, pb0, kt + 2);
    compute(0);
    lstore(pa1, pb1, 1);
    __syncthreads();
    gload(pa1, pb1, kt + 3);
    compute(1);
    lstore(pa0, pb0, 0);
    __syncthreads();
  }
  compute(0);
  lstore(pa1, pb1, 1);
  __syncthreads();
  compute(1);
  __syncthreads();
  float* Cs = (float*)sm;
#pragma unroll
  for (int m = 0; m < MI; ++m)
#pragma unroll
    for (int n = 0; n < 4; ++n)
#pragma unroll
      for (int j = 0; j < 4; ++j)
        Cs[(wr * MI * 16 + m * 16 + fq * 4 + j) * 132 + wc * 64 + n * 16 + fr] = acc[m][n][j];
  __syncthreads();
  ep(Cs);
  __syncthreads();
}
template <int BM, class F>
DI void for_chunks(F f) {
  const int tid = TID();
#pragma unroll 2
  for (int it = 0; it < BM / 16; ++it) {
    int idx = tid + 256 * it;
    f(idx >> 4, (idx & 15) * 8);
  }
}
DI void ld8(const float* s, float* v) {
  float4 a = *(const float4*)s, b = *(const float4*)(s + 4);
  v[0] = a.x; v[1] = a.y; v[2] = a.z; v[3] = a.w; v[4] = b.x; v[5] = b.y; v[6] = b.z; v[7] = b.w;
}
DI void st8(float* d, const float* v) {
  *(float4*)d = float4{v[0], v[1], v[2], v[3]};
  *(float4*)(d + 4) = float4{v[4], v[5], v[6], v[7]};
}
DI void st8bf(u16* d, const float* v) {
  u32x4 o = {pack2(v[0], v[1]), pack2(v[2], v[3]), pack2(v[4], v[5]), pack2(v[6], v[7])};
  *(u32x4*)d = o;
}
DI void st8bf_wt(u16* d, const float* v) {
  u32x4 o = {pack2(v[0], v[1]), pack2(v[2], v[3]), pack2(v[4], v[5]), pack2(v[6], v[7])};
  asm volatile("global_store_dwordx4 %0, %1, off sc0 sc1" :: "v"(d), "v"(o) : "memory");
}
DI void ld8bf(const u16* s, float* v) {
  u32x4 o = *(const u32x4*)s;
#pragma unroll
  for (int e = 0; e < 4; ++e) { v[2 * e] = __uint_as_float(o[e] << 16); v[2 * e + 1] = __uint_as_float(o[e] & 0xffff0000u); }
}

DI void chain_done(unsigned* cnt);
DI void wait_chains(unsigned* cnt, unsigned need);
DI void transpose_tile(float* tl, const float* __restrict__ src, int ldn, u16* __restrict__ dst, int ldk, int kt, int nt, unsigned* cnt = nullptr) {
  const int tid = TID();
#pragma unroll
  for (int i = 0; i < 4; ++i) {
    int kk = (tid >> 4) + 16 * i, c4 = (tid & 15) * 4;
    float4 v = *(const float4*)(src + (size_t)(kt * 64 + kk) * ldn + nt * 64 + c4);
    tl[kk * 65 + c4 + 0] = v.x; tl[kk * 65 + c4 + 1] = v.y; tl[kk * 65 + c4 + 2] = v.z; tl[kk * 65 + c4 + 3] = v.w;
  }
  __syncthreads();
  {
    int n = tid >> 2, ks = (tid & 3) * 16;
    u32x4 o0, o1;
#pragma unroll
    for (int e = 0; e < 4; ++e) {
      o0[e] = pack2(tl[(ks + 2 * e) * 65 + n], tl[(ks + 2 * e + 1) * 65 + n]);
      o1[e] = pack2(tl[(ks + 8 + 2 * e) * 65 + n], tl[(ks + 8 + 2 * e + 1) * 65 + n]);
    }
    u16* d = dst + (size_t)(nt * 64 + n) * ldk + kt * 64 + ks;
    if (cnt) {
      asm volatile("global_store_dwordx4 %0, %1, off sc0 sc1" :: "v"(d), "v"(o0) : "memory");
      asm volatile("global_store_dwordx4 %0, %1, off offset:16 sc0 sc1" :: "v"(d), "v"(o1) : "memory");
    } else {
      *(u32x4*)d = o0;
      *(u32x4*)(d + 8) = o1;
    }
  }
  if (cnt) chain_done(cnt); else __syncthreads();
}
DI void ssm_tables(const Params& p, float* sm, int lg, int cq) {
  float* pwr = sm;            float* pwi = pwr + 17 * 64;
  float* bbr = pwi + 17 * 64; float* bbi = bbr + 1024;
  float* cr = bbi + 1024;     float* ci = cr + 1024;
  float* Kt = ci + 1024;
  const int tid = TID();
  const float dt = expf(p.log_dt[lg]);
  const float* are = p.a_re + lg * 64;
  const float* aim = p.a_im + lg * 64;
  for (int idx = tid; idx < 17 * 64; idx += 256) {
    int pp = idx & 63, tau = idx >> 6;
    float mag = expf(are[pp] * dt * (float)tau);
    float sn, cs;
    sincosf(aim[pp] * dt * (float)tau, &sn, &cs);
    pwr[idx] = mag * cs; pwi[idx] = mag * sn;
  }
  {
    int pp = tid >> 2, c0 = (tid & 3) * 4;
    float ar = are[pp], ai = aim[pp];
    float x = ar * dt, y = ai * dt;
    float sn, cs, sh, chh;
    sincosf(y, &sn, &cs);
    sincosf(0.5f * y, &sh, &chh);
    float em1 = expm1f(x);
    float nr = em1 * cs - 2.f * sh * sh;
    float ni = (em1 + 1.f) * sn;
    float den = ar * ar + ai * ai;
    float cre = (nr * ar + ni * ai) / den;
    float cim = (ni * ar - nr * ai) / den;
#pragma unroll
    for (int e = 0; e < 4; ++e) {
      float br = p.b_re[(size_t)lg * 1024 + pp * 16 + c0 + e];
      float bi = p.b_im[(size_t)lg * 1024 + pp * 16 + c0 + e];
      bbr[pp * 16 + c0 + e] = cre * br - cim * bi;
      bbi[pp * 16 + c0 + e] = cre * bi + cim * br;
    }
  }
  for (int idx = tid; idx < 1024; idx += 256) {
    cr[idx] = p.c_re[(size_t)lg * 1024 + idx];
    ci[idx] = p.c_im[(size_t)lg * 1024 + idx];
  }
  __syncthreads();
#pragma unroll 1
  for (int e = tid; e < 1024; e += 256) {
    int tau = e >> 6, cl = (e >> 4) & 3, c2 = e & 15, c = cq * 4 + cl;
    float s = 0.f;
#pragma unroll 8
    for (int pp = 0; pp < 64; ++pp) {
      float wr_ = pwr[tau * 64 + pp], wi_ = pwi[tau * 64 + pp];
      float br = bbr[pp * 16 + c2], bi = bbi[pp * 16 + c2];
      float zr = wr_ * br - wi_ * bi, zi = wr_ * bi + wi_ * br;
      s += cr[c * 64 + pp] * zr - ci[c * 64 + pp] * zi;
    }
    if (tau == 0 && c == c2) s += p.ssm_d[lg * 16 + c];
    Kt[e] = s;
  }
  __syncthreads();
  u16* bt2 = ((u16*)(WS(p) + W_BT2)) + (size_t)lg * 256 * LDB2;
#pragma unroll 1
  for (int r = 0; r < 64; ++r) {
    int t = r >> 2, cl = r & 3, c = cq * 4 + cl, n = t * 16 + c;
    {
      int k = tid, s = k >> 4, c2 = k & 15;
      float v = (s <= t) ? Kt[((t - s) << 6) + (cl << 4) + c2] : 0.f;
      bt2[n * LDB2 + k] = f2bf(v);
    }
    if (tid < 128) {
      int pp = tid & 63;
      float wr_ = pwr[(t + 1) * 64 + pp], wi_ = pwi[(t + 1) * 64 + pp];
      float crr = cr[c * 64 + pp], cii = ci[c * 64 + pp];
      float v = (tid < 64) ? (crr * wr_ - cii * wi_) : -(crr * wi_ + cii * wr_);
      bt2[n * LDB2 + 256 + tid] = f2bf(v);
    }
  }
  u16* bt1 = ((u16*)(WS(p) + W_BT1)) + (size_t)lg * 128 * LDB1;
  {
    int k = tid, s = k >> 4, c = k & 15;
#pragma unroll 4
    for (int r = 0; r < 32; ++r) {
      int n = cq * 32 + r, pp = n & 63;
      float wr_ = pwr[(15 - s) * 64 + pp], wi_ = pwi[(15 - s) * 64 + pp];
      float br = bbr[pp * 16 + c], bi = bbi[pp * 16 + c];
      float v = (n < 64) ? (wr_ * br - wi_ * bi) : (wr_ * bi + wi_ * br);
      bt1[n * LDB1 + k] = f2bf(v);
    }
  }
  if (cq == 0 && tid < 64) {
    float* ap = ((float*)(WS(p) + W_APOW)) + (size_t)lg * 256;
    ap[tid] = pwr[16 * 64 + tid]; ap[64 + tid] = pwi[16 * 64 + tid];
    ap[128 + tid] = pwr[8 * 64 + tid]; ap[192 + tid] = pwi[8 * 64 + tid];
  }
  __syncthreads();
}

DI void mod_tile(const Params& p, char* smem, int t);
DI void phase_prep(const Params& p, char* smem) {
  const int tid = TID();
  constexpr int N_TAB = 512, N_ROPE = 1, N_SC = 16, N_TR = 6656, N_CP = 1024;
  constexpr int N_MOD = 288;
  constexpr int total = N_TAB + N_ROPE + N_SC + N_TR + N_CP + N_MOD;
  for (int it = BID(); it < total; it += gridDim.x) {
    int i = it;
    if (i < N_TAB) { ssm_tables(p, (float*)smem, i >> 2, i & 3); continue; }
    i -= N_TAB;
    if (i < N_ROPE) {
      for (int e = tid; e < 2056 * 8; e += 256) {
        int pi = e >> 3, j = e & 7;
        float pos = (float)(pi < 2048 ? pi : PAST + (pi - 2048));
        float inv = powf(500000.0f, -(float)j / 8.0f);
        float sn, cs;
        sincosf(pos * inv, &sn, &cs);
        ((float*)(WS(p) + W_ROPE))[e] = cs; ((float*)(WS(p) + W_ROPE))[2056 * 8 + e] = sn;
      }
      continue;
    }
    i -= N_ROPE;
    if (i < N_SC) {
      for (int e = tid; e < 16 * 1024; e += 256) {
        int r = i * 16 + (e >> 10), c = e & 1023;
        float v = 0.f;
        if (r < NB) v = silu_f(p.c_prompt[r * D + c]);
        else if (r < NROWS_C) v = silu_f(p.c_sample[(r - NB) * D + c]);
        ((u16*)(WS(p) + W_SC))[r * D + c] = f2bf(v);
      }
      continue;
    }
    i -= N_SC;
    if (i < N_TR) {
      float* tl = (float*)smem;
      if (i < 3072) { int l = i / 768, rem = i % 768; transpose_tile(tl, p.w_ada + (size_t)l * 1024 * 3072, 3072, ((u16*)(WS(p) + W_WT_ADA)) + (size_t)l * 3072 * LDA, LDA, rem / 48, rem % 48, (unsigned*)(WS(p) + W_MODCNT) + (l * 24 + (rem % 48) / 2) * 16); }
      else if (i < 5376) { int j = i - 3072; int l = j / 576, rem = j % 576; transpose_tile(tl, p.w_in + (size_t)l * 1024 * 2304, 2304, ((u16*)(WS(p) + W_WT_IN)) + (size_t)l * 2304 * LDA, LDA, rem / 36, rem % 36); }
      else if (i < 5632) { int j = i - 5376; int l = j / 64, rem = j % 64; transpose_tile(tl, p.w_glu + (size_t)l * 512 * 512, 512, ((u16*)(WS(p) + W_WT_GLU)) + (size_t)l * 512 * LDH, LDH, rem / 8, rem % 8); }
      else { int j = i - 5632; int l = j / 256, rem = j % 256; transpose_tile(tl, p.w_out + (size_t)l * 1024 * 1024, 1024, ((u16*)(WS(p) + W_WT_OUT)) + (size_t)l * 1024 * LDA, LDA, rem / 16, rem % 16); }
      continue;
    }
    i -= N_TR;
    if (i < N_CP) {
      int which = i >> 9, lb = i & 511;
      const float4* src = (const float4*)((which ? p.cache_v : p.cache_k) + (size_t)lb * 16384 + 8 * 128);
      float4* dst = (float4*)(OUTP(p) + (which ? O_VS : O_KS) + (size_t)lb * 16384);
      for (int e = tid; e < 3840; e += 256) dst[e] = src[e];
      continue;
    }
    i -= N_CP;
    mod_tile(p, smem, i);
  }
}
DI void mod_tile(const Params& p, char* smem, int t) {
  const int mt = t / 96, nt = t % 96;
  const int m0 = mt * 64, n0 = nt * 128;
  const int l = n0 / 3072, cb = n0 - l * 3072;
  wait_chains((unsigned*)(WS(p) + W_MODCNT) + (l * 24 + cb / 128) * 16, 32u * 256u);
  auto al = [&](int row, int k) {
    u32x4 o = {0u, 0u, 0u, 0u};
    if (row < NROWS_C) {
      const float* c = (row < NB) ? p.c_prompt + (size_t)row * D + k : p.c_sample + (size_t)(row - NB) * D + k;
      float4 a = *(const float4*)c, bb = *(const float4*)(c + 4);
      o[0] = pack2(silu_f(a.x), silu_f(a.y)); o[1] = pack2(silu_f(a.z), silu_f(a.w));
      o[2] = pack2(silu_f(bb.x), silu_f(bb.y)); o[3] = pack2(silu_f(bb.z), silu_f(bb.w));
    }
    return __builtin_bit_cast(bf16x8, o);
  };
  auto ep = [&](const float* Cs) {
    float* md = ((float*)(WS(p) + W_MOD));
    for_chunks<64>([&](int row, int c8) {
      int r = m0 + row;
      if (r < NROWS_C) {
        float v[8], b[8];
        ld8(Cs + row * 132 + c8, v);
        ld8(p.b_ada + l * 3072 + cb + c8, b);
#pragma unroll
        for (int e = 0; e < 8; ++e) v[e] += b[e];
        st8(md + ((size_t)l * NROWS_C + r) * 3072 + cb + c8, v);
      }
    });
  };
  gemm_tile<2>((u16*)smem, m0, n0, 1024, al, ((u16*)(WS(p) + W_WT_ADA)), LDA, 1 << 30, 0, ep);
}

DI void phase_norm(const Params& p, int l) {
  const int lane = TID() & 63, wid = TID() >> 6;
  const float* g = p.norm_g + l * D;
  for (int m = BID() * 4 + wid; m < NTOK; m += gridDim.x * 4) {
    const float* xr = (l == 0) ? xrow_in(p, m) : OUTP(p) + (size_t)m * D;
    const float* md = ((float*)(WS(p) + W_MOD)) + ((size_t)l * NROWS_C + brow_of(m)) * 3072;
    float4 v[4];
    float ss = 0.f;
#pragma unroll
    for (int i = 0; i < 4; ++i) {
      v[i] = *(const float4*)(xr + lane * 4 + 256 * i);
      ss += v[i].x * v[i].x + v[i].y * v[i].y + v[i].z * v[i].z + v[i].w * v[i].w;
    }
#pragma unroll
    for (int o = 32; o > 0; o >>= 1) ss += __shfl_xor(ss, o);
    float rstd = rsqrtf(ss * (1.f / D) + 1e-6f);
#pragma unroll
    for (int i = 0; i < 4; ++i) {
      int c = lane * 4 + 256 * i;
      float4 gg = *(const float4*)(g + c);
      float4 sh = *(const float4*)(md + c);
      float4 sc = *(const float4*)(md + 1024 + c);
      float a0 = v[i].x * rstd * gg.x * (1.f + sc.x) + sh.x;
      float a1 = v[i].y * rstd * gg.y * (1.f + sc.y) + sh.y;
      float a2 = v[i].z * rstd * gg.z * (1.f + sc.z) + sh.z;
      float a3 = v[i].w * rstd * gg.w * (1.f + sc.w) + sh.w;
      u32x2 o = {pack2(a0, a1), pack2(a2, a3)};
      *(u32x2*)(((u16*)(WS(p) + W_HN)) + (size_t)m * LDA + c) = o;
    }
  }
}
DI void phase_inproj(const Params& p, char* smem, int l, int vx, int vj) {
  constexpr int NT = INW / 128;
  constexpr int MT = NTOK / 128;
  const u16* Bt = ((u16*)(WS(p) + W_WT_IN)) + (size_t)l * INW * LDA;
  const int xcd = vx, nxb = gridDim.x >> 3;
  constexpr int PW = 9, MX = MT / 8;
  for (int i = vj; i < MX * NT; i += nxb) {
    int panel = i / (MX * PW), r = i - panel * (MX * PW);
    int mt = xcd * MX + r / PW, nt = panel * PW + r % PW;
    const int m0 = mt * 128, n0 = nt * 128;
    const u16* A = ((u16*)(WS(p) + W_HN));
    auto al = [&](int row, int k) { return *(const bf16x8*)(A + (size_t)row * LDA + k); };
    auto ep = [&](const float* Cs) {
      float* out = OUTP(p);
      if (nt < 5) {
        const float* rope = ((float*)(WS(p) + W_ROPE));
        u16* qd = ((u16*)(WS(p) + W_Q));
        u16* kd = ((u16*)(WS(p) + W_K));
        for_chunks<128>([&](int row, int c8) {
          const int m = m0 + row;
          const bool is_p = m < NTOK_P;
          int b, pos, ridx;
          if (is_p) { b = m >> 11; pos = m & 2047; ridx = pos; }
          else { int rr = m - NTOK_P; b = rr >> 3; pos = rr & 7; ridx = 2048 + pos; }
          float v[8];
          const float* c = Cs + row * 132 + c8;
          ld8(c, v);
          const int dd = c8 & 63;
          if (dd < 16) {
            float cs[8], sn[8], o[8];
            ld8(rope + ridx * 8, cs);
            ld8(rope + 2056 * 8 + ridx * 8, sn);
            if (dd == 0) { ld8(c + 8, o);
#pragma unroll
              for (int e = 0; e < 8; ++e) v[e] = v[e] * cs[e] - o[e] * sn[e];
            } else { ld8(c - 8, o);
#pragma unroll
              for (int e = 0; e < 8; ++e) v[e] = v[e] * cs[e] + o[e] * sn[e];
            }
          }
          if (nt < 4) st8bf(qd + (size_t)m * LDH + n0 + c8, v);
          else {
            st8bf(kd + (size_t)m * 128 + c8, v);
            if (is_p) { if (pos >= SEQ - 128) st8(out + O_KP + ((size_t)(l * NB + b) * 128 + (pos - (SEQ - 128))) * 128 + c8, v); }
            else st8(out + O_KS + ((size_t)(l * DB + b) * 128 + 120 + pos) * 128 + c8, v);
          }
        });
      } else if (nt == 5) {
        u16* vT = ((u16*)(WS(p) + W_VT));
        const int tid = TID();
#pragma unroll 2
        for (int it = 0; it < 8; ++it) {
          int idx = tid + 256 * it, col = idx & 127, rg = idx >> 7;
          const int m = m0 + rg * 8;
          float v[8];
#pragma unroll
          for (int e = 0; e < 8; ++e) v[e] = Cs[(rg * 8 + e) * 132 + col];
          if (m < NTOK_P) {
            int b = m >> 11, pos0 = m & 2047;
            st8bf(vT + ((size_t)(b * 128 + col)) * LDV + pos0, v);
            if (pos0 >= SEQ - 128) {
#pragma unroll
              for (int e = 0; e < 8; ++e) out[O_VP + ((size_t)(l * NB + b) * 128 + (pos0 + e - (SEQ - 128))) * 128 + col] = v[e];
            }
          } else {
            int b = (m - NTOK_P) >> 3;
            st8bf(vT + (size_t)NB * 128 * LDV + ((size_t)(b * 128 + col)) * 8, v);
#pragma unroll
            for (int e = 0; e < 8; ++e) out[O_VS + ((size_t)(l * DB + b) * 128 + 120 + e) * 128 + col] = v[e];
          }
        }
      } else {
        u16* dst; int cb;
        if (nt < 10) { dst = ((u16*)(WS(p) + W_ZA)); cb = n0 - 768; }
        else if (nt < 14) { dst = ((u16*)(WS(p) + W_U)); cb = n0 - 1280; }
        else { dst = ((u16*)(WS(p) + W_ZS)); cb = n0 - 1792; }
        const bool is_u = (nt >= 10) && (nt < 14);
        for_chunks<128>([&](int row, int c8) {
          float v[8];
          ld8(Cs + row * 132 + c8, v);
          const int c = cb + c8;
          if (is_u) st8bf(dst + ((size_t)(c >> 4) * NTOK + (m0 + row)) * 16 + (c & 15), v);
          else st8bf(dst + (size_t)(m0 + row) * LDH + c, v);
        });
      }
    };
    gemm_tile<4>((u16*)smem, m0, n0, 1024, al, Bt, LDA, 1 << 30, 0, ep);
  }
}

DI int crow(int i, int h) { return (i & 3) + 8 * (i >> 2) + 4 * h; }

template <bool SAMPLE>
DI void attn_task(const Params& p, int l, const u16* Ks, const u16* Vt, int VS, int koff, int kp0,
                  const u16* qptr, int qp, float sink, int tok_base, int head_base) {
  const int lane = TID() & 63, r = lane & 31, h = lane >> 5;
  bf16x8 qf[4];
#pragma unroll
  for (int s = 0; s < 4; ++s) qf[s] = *(const bf16x8*)(qptr + 16 * s + 8 * h);
  f32x16 sc[5];
#pragma unroll
  for (int t = 0; t < 5; ++t) {
    f32x16 acc;
#pragma unroll
    for (int i = 0; i < 16; ++i) acc[i] = 0.f;
#pragma unroll
    for (int s = 0; s < 4; ++s) {
      bf16x8 a = *(const bf16x8*)(Ks + (koff + t * 32 + r) * 72 + 16 * s + 8 * h);
      acc = __builtin_amdgcn_mfma_f32_32x32x16_bf16(a, qf[s], acc, 0, 0, 0);
    }
    sc[t] = acc;
  }
  float m = sink;
#pragma unroll
  for (int t = 0; t < 5; ++t)
#pragma unroll
    for (int i = 0; i < 16; ++i) {
      int kp = kp0 + koff + t * 32 + crow(i, h);
      int df = qp - kp;
      bool valid = (df >= 0) && (df <= 128) && (kp >= 0);
      float s = valid ? sc[t][i] * 0.125f : -1e30f;
      sc[t][i] = s;
      m = fmaxf(m, s);
    }
  m = fmaxf(m, __shfl_xor(m, 32));
  float lsum = 0.f;
#pragma unroll
  for (int t = 0; t < 5; ++t)
#pragma unroll
    for (int i = 0; i < 16; ++i) {
      float e = __expf(sc[t][i] - m);
      sc[t][i] = e;
      lsum += e;
    }
  lsum += __shfl_xor(lsum, 32);
  float inv = 1.f / (lsum + __expf(sink - m));
  f32x16 o[2];
#pragma unroll
  for (int i = 0; i < 16; ++i) { o[0][i] = 0.f; o[1][i] = 0.f; }
#pragma unroll
  for (int t = 0; t < 5; ++t)
#pragma unroll
    for (int s = 0; s < 2; ++s) {
      u32x4 pk;
#pragma unroll
      for (int e = 0; e < 4; ++e) pk[e] = pack2(sc[t][8 * s + 2 * e], sc[t][8 * s + 2 * e + 1]);
      bf16x8 pa = __builtin_bit_cast(bf16x8, pk);
      int kb = koff + t * 32 + 16 * s + 4 * h;
#pragma unroll
      for (int dt = 0; dt < 2; ++dt) {
        const u16* vp = Vt + (dt * 32 + r) * VS + kb;
        s16x4 lo = *(const s16x4*)vp;
        s16x4 hi = *(const s16x4*)(vp + 8);
        bf16x8 vb = __builtin_shufflevector(lo, hi, 0, 1, 2, 3, 4, 5, 6, 7);
        o[dt] = __builtin_amdgcn_mfma_f32_32x32x16_bf16(pa, vb, o[dt], 0, 0, 0);
      }
    }
  u16 zz[32];
#pragma unroll
  for (int i = 0; i < 16; ++i) {
    int row = crow(i, h);
    int tok, head;
    if (SAMPLE) { tok = tok_base + (row & 7); head = head_base + (row >> 3); }
    else { tok = tok_base + row; head = head_base; }
#pragma unroll
    for (int dt = 0; dt < 2; ++dt) zz[i * 2 + dt] = ((const u16*)(WS(p) + W_ZA))[(size_t)tok * LDH + head * 64 + dt * 32 + r];
  }
#pragma unroll
  for (int i = 0; i < 16; ++i) {
    int row = crow(i, h);
    float iq = __shfl(inv, row);
    int tok, head;
    if (SAMPLE) { tok = tok_base + (row & 7); head = head_base + (row >> 3); }
    else { tok = tok_base + row; head = head_base; }
#pragma unroll
    for (int dt = 0; dt < 2; ++dt) {
      int c = head * 64 + dt * 32 + r;
      float z = bf2f(zz[i * 2 + dt]);
      ((u16*)(WS(p) + W_MIX))[(size_t)tok * LDA + c] = f2bf(o[dt][i] * iq * silu_f(z));
    }
  }
}

DI void attn_prompt_item(const Params& p, char* smem, int l, int it) {
  const int tid = TID(), wid = tid >> 6, lane = tid & 63;
  const int b = it >> 6, h = (it >> 5) & 1, n = (it >> 1) & 15, half = it & 1;
  const int qb = n * 128 + half * 64, kstart = qb - 128;
  u16* Ks = (u16*)smem;
  u16* Vt = Ks + 192 * 72;
  for (int idx = tid; idx < 192 * 8; idx += 256) {
    int key = idx >> 3, ch = idx & 7, pos = kstart + key;
    bf16x8 v = {0, 0, 0, 0, 0, 0, 0, 0};
    if (pos >= 0) v = *(const bf16x8*)(((u16*)(WS(p) + W_K)) + ((size_t)(b * SEQ + pos)) * 128 + h * 64 + ch * 8);
    *(bf16x8*)(Ks + key * 72 + ch * 8) = v;
  }
  for (int idx = tid; idx < 64 * 24; idx += 256) {
    int d = idx / 24, ch = idx - d * 24, pos0 = kstart + ch * 8;
    s16x4 lo = {0, 0, 0, 0}, hi = {0, 0, 0, 0};
    if (pos0 >= 0) {
      const u16* src = ((u16*)(WS(p) + W_VT)) + ((size_t)((b * 2 + h) * 64 + d)) * LDV + pos0;
      lo = *(const s16x4*)src; hi = *(const s16x4*)(src + 4);
    }
    *(s16x4*)(Vt + d * 196 + ch * 8) = lo;
    *(s16x4*)(Vt + d * 196 + ch * 8 + 4) = hi;
  }
  __syncthreads();
  const int head = h * 4 + wid;
  const float sink = p.sinks[l * 8 + head];
#pragma unroll 1
  for (int r = 0; r < 2; ++r) {
    int q0 = qb + r * 32;
    const u16* qptr = ((u16*)(WS(p) + W_Q)) + ((size_t)(b * SEQ + q0 + (lane & 31))) * LDH + head * 64;
    attn_task<false>(p, l, Ks, Vt, 196, r * 32, kstart, qptr, q0 + (lane & 31), sink, b * SEQ + q0, head);
  }
  __syncthreads();
}

DI void attn_sample_item(const Params& p, char* smem, int l, int it) {
  const int tid = TID(), wid = tid >> 6, lane = tid & 63;
  const int b = it >> 1, h = it & 1;
  u16* Ks = (u16*)smem;
  u16* Vt = Ks + 160 * 72;
  const float* ck = p.cache_k + ((size_t)(l * DB + b)) * 16384 + h * 64;
  const float* cv = p.cache_v + ((size_t)(l * DB + b)) * 16384 + h * 64;
  for (int idx = tid; idx < 160 * 16; idx += 256) {
    int key = idx >> 4, c4 = (idx & 15) * 4;
    u32x2 o = {0u, 0u};
    if (key < 128) {
      float4 v = *(const float4*)(ck + (size_t)key * 128 + c4);
      o[0] = pack2(v.x, v.y); o[1] = pack2(v.z, v.w);
    } else if (key < 136) {
      o = *(const u32x2*)(((u16*)(WS(p) + W_K)) + ((size_t)(NTOK_P + b * 8 + key - 128)) * 128 + h * 64 + c4);
    }
    *(u32x2*)(Ks + key * 72 + c4) = o;
  }
  for (int idx = tid; idx < 128 * 16; idx += 256) {
    int key = idx >> 4, c4 = (idx & 15) * 4;
    float4 v = *(const float4*)(cv + (size_t)key * 128 + c4);
    Vt[(c4 + 0) * 164 + key] = f2bf(v.x);
    Vt[(c4 + 1) * 164 + key] = f2bf(v.y);
    Vt[(c4 + 2) * 164 + key] = f2bf(v.z);
    Vt[(c4 + 3) * 164 + key] = f2bf(v.w);
  }
  if (tid < 64) {
    int d = tid;
    const u16* src = ((u16*)(WS(p) + W_VT)) + (size_t)NB * 128 * LDV + ((size_t)((b * 2 + h) * 64 + d)) * 8;
    s16x4 lo = *(const s16x4*)src, hi = *(const s16x4*)(src + 4);
    s16x4 z = {0, 0, 0, 0};
    u16* dst = Vt + d * 164 + 128;
    *(s16x4*)dst = lo; *(s16x4*)(dst + 4) = hi;
#pragma unroll
    for (int e = 2; e < 8; ++e) *(s16x4*)(dst + 4 * e) = z;
  }
  __syncthreads();
  if (wid == 0) {
    int r = lane & 31, g = r >> 3, t = r & 7;
    const u16* qptr = ((u16*)(WS(p) + W_Q)) + ((size_t)(NTOK_P + b * 8 + t)) * LDH + (h * 4 + g) * 64;
    float sink = p.sinks[l * 8 + h * 4 + g];
    attn_task<true>(p, l, Ks, Vt, 164, 0, PAST - 128, qptr, PAST + t, sink, NTOK_P + b * 8, h * 4);
  }
  __syncthreads();
}
DI void ssm_g1_tile(const Params& p, char* smem, int l, int it) {
  const bool smp = it >= 256;
  const int g = smp ? it - 256 : (it & 31);
  const int mt = smp ? 0 : (it >> 5);
  const u16* U = ((u16*)(WS(p) + W_U));
  auto al = [&](int row, int k) {
    int tok = smp ? (NTOK_P + row * 8 + (k >> 4)) : (row * 16 + (k >> 4));
    return *(const bf16x8*)(U + ((size_t)g * NTOK + tok) * 16 + (k & 15));
  };
  const float* ap = ((float*)(WS(p) + W_APOW)) + (size_t)(l * 32 + g) * 256;
  auto ep = [&](const float* Csc) {
    float* Cs = const_cast<float*>(Csc);
    float* out = OUTP(p);
    const int tid = TID();
    if (smp) {
      u16* cr = ((u16*)(WS(p) + W_CARRY_S));
      for_chunks<128>([&](int row, int c8) {
        const int b = row, pp = c8 & 63;
        const bool im = c8 >= 64;
        float s[8], hr[8], hi[8], ar[8], ai[8], o[8];
        ld8(Cs + row * 132 + c8, s);
        size_t si = ((size_t)(l * DB + b) * 32 + g) * 64 + pp;
        ld8(p.st_re + si, hr); ld8(p.st_im + si, hi);
        ld8(ap + 128 + pp, ar); ld8(ap + 192 + pp, ai);
#pragma unroll
        for (int e = 0; e < 8; ++e) o[e] = im ? (ar[e] * hi[e] + ai[e] * hr[e] + s[e]) : (ar[e] * hr[e] - ai[e] * hi[e] + s[e]);
        st8(out + (im ? O_SIS : O_SRS) + si, o);
        st8bf(cr + ((size_t)g * DB + b) * 128 + c8, im ? hi : hr);
      });
    } else {
      const int b = mt;
      const int pp = tid & 63, sg = tid >> 6;
      const float ar = ap[pp], ai = ap[64 + pp];
      float hr = 0.f, hi = 0.f;
#pragma unroll 4
      for (int j = sg * 32; j < sg * 32 + 32; ++j) {
        float sr = Cs[j * 132 + pp], si = Cs[j * 132 + 64 + pp];
        float nr = ar * hr - ai * hi + sr, ni = ar * hi + ai * hr + si;
        hr = nr; hi = ni;
      }
      float pr = ar, pi = ai;
#pragma unroll
      for (int q = 0; q < 5; ++q) { float t = pr * pr - pi * pi; pi = 2.f * pr * pi; pr = t; }
      float* Ls = Cs + 128 * 132;
      Ls[sg * 128 + pp] = hr; Ls[sg * 128 + 64 + pp] = hi;
      __syncthreads();
      float cr_ = 0.f, ci_ = 0.f;
      for (int s2 = 0; s2 < sg; ++s2) {
        float lr = Ls[s2 * 128 + pp], li = Ls[s2 * 128 + 64 + pp];
        float nr = pr * cr_ - pi * ci_ + lr, ni = pr * ci_ + pi * cr_ + li;
        cr_ = nr; ci_ = ni;
      }
      hr = cr_; hi = ci_;
#pragma unroll 4
      for (int j = sg * 32; j < sg * 32 + 32; ++j) {
        float sr = Cs[j * 132 + pp], si = Cs[j * 132 + 64 + pp];
        Cs[j * 132 + pp] = hr; Cs[j * 132 + 64 + pp] = hi;
        float nr = ar * hr - ai * hi + sr, ni = ar * hi + ai * hr + si;
        hr = nr; hi = ni;
      }
      if (sg == 3) {
        out[O_SRP + ((size_t)(l * NB + b) * 32 + g) * 64 + pp] = hr;
        out[O_SIP + ((size_t)(l * NB + b) * 32 + g) * 64 + pp] = hi;
      }
      __syncthreads();
      u16* cr = ((u16*)(WS(p) + W_CARRY_P));
      for_chunks<128>([&](int row, int c8) {
        float v[8];
        ld8(Cs + row * 132 + c8, v);
        st8bf(cr + ((size_t)g * NCH_P + (b * 128 + row)) * 128 + c8, v);
      });
    }
  };
  const u16* Bt = ((u16*)(WS(p) + W_BT1)) + (size_t)(l * 32 + g) * 128 * LDB1 + (smp ? 128 : 0);
  gemm_tile<4>((u16*)smem, mt * 128, 0, smp ? 128 : 256, al, Bt, LDB1, 1 << 30, 0, ep);
}

DI void ssm_y_tile(const Params& p, char* smem, int l, int it) {
  {
    const bool smp = it >= 512;
    int g, mt, nt;
    if (smp) { g = it - 512; mt = 0; nt = 0; }
    else { g = it & 31; nt = (it >> 5) & 1; mt = it >> 6; }
    const int KU = (smp || nt == 0) ? 128 : 256;
    const int m0 = mt * 128, n0 = nt * 128;
    const u16* U = ((u16*)(WS(p) + W_U));
    const u16* CR = smp ? ((u16*)(WS(p) + W_CARRY_S)) : ((u16*)(WS(p) + W_CARRY_P));
    auto al = [&](int row, int k) {
      if (k < KU) {
        int tok = smp ? (NTOK_P + row * 8 + (k >> 4)) : (row * 16 + (k >> 4));
        return *(const bf16x8*)(U + ((size_t)g * NTOK + tok) * 16 + (k & 15));
      } else {
        return *(const bf16x8*)(CR + ((size_t)g * (smp ? DB : NCH_P) + row) * 128 + (k - KU));
      }
    };
    auto ep = [&](const float* Cs) {
      u16* yg = ((u16*)(WS(p) + W_YG));
      for_chunks<128>([&](int row, int c8) {
        int col = n0 + c8, t = col >> 4, c0 = col & 15;
        int tok = smp ? (NTOK_P + (m0 + row) * 8 + t) : ((m0 + row) * 16 + t);
        float v[8];
        ld8(Cs + row * 132 + c8, v);
#pragma unroll
        for (int e = 0; e < 8; ++e) v[e] = gelu_tanh(v[e]);
        st8bf_wt(yg + (size_t)tok * LDH + g * 16 + c0, v);
      });
    };
    const u16* Bt = ((u16*)(WS(p) + W_BT2)) + (size_t)(l * 32 + g) * 256 * LDB2;
    gemm_tile<4>((u16*)smem, m0, n0, KU + 128, al, Bt, LDB2, KU, 256 - KU, ep);
  }
}

template <int MI>
DI void glu_tile(const Params& p, char* smem, int l, int m0, int n0) {
  constexpr int BM = 32 * MI;
  const u16* Bt = ((u16*)(WS(p) + W_WT_GLU)) + (size_t)l * 512 * LDH;
  const u16* A = ((u16*)(WS(p) + W_YG));
  auto al = [&](int row, int k) { return *(const bf16x8*)(A + (size_t)row * LDH + k); };
  auto ep = [&](const float* Cs) {
    const u16* yg = ((u16*)(WS(p) + W_YG));
    const u16* zs = ((u16*)(WS(p) + W_ZS));
    u16* mix = ((u16*)(WS(p) + W_MIX));
    for_chunks<BM>([&](int row, int c8) {
      const int m = m0 + row, col = n0 + c8;
      float v[8], y[8], z[8], bg[8];
      ld8(Cs + row * 132 + c8, v);
      ld8bf(yg + (size_t)m * LDH + col, y);
      ld8bf(zs + (size_t)m * LDH + col, z);
      ld8(p.b_glu + l * 512 + col, bg);
#pragma unroll
      for (int e = 0; e < 8; ++e) v[e] = y[e] * sigmoid_f(v[e] + bg[e]) * silu_f(z[e]);
      st8bf(mix + (size_t)m * LDA + 512 + col, v);
    });
  };
  gemm_tile<MI>((u16*)smem, m0, n0, 512, al, Bt, LDH, 1 << 30, 0, ep);
}
DI void chain_done(unsigned* cnt) {
  asm volatile("s_waitcnt vmcnt(0)" ::: "memory");
  __syncthreads();
  (void)__hip_atomic_fetch_add(cnt, 1u, __ATOMIC_RELAXED, __HIP_MEMORY_SCOPE_AGENT);
}
DI void wait_chains(unsigned* cnt, unsigned need) {
  unsigned sp = 0;
  for (;;) {
    const unsigned v = (unsigned)__builtin_amdgcn_readfirstlane((int)__hip_atomic_load(cnt, __ATOMIC_RELAXED, __HIP_MEMORY_SCOPE_AGENT));
    if (v >= need) break;
    __builtin_amdgcn_s_sleep(8);
    if (++sp > (1u << 14)) break;
  }
  __builtin_amdgcn_fence(__ATOMIC_ACQUIRE, "agent");
  asm volatile("s_waitcnt vmcnt(0)" ::: "memory");
  __syncthreads();
}

DI void phase_attn(const Params& p, char* smem, int l, int* q_slot) {
  unsigned* base = (unsigned*)(WS(p) + W_QUEUE) + (size_t)l * 16 * 64;
  for (;;) {
    if (threadIdx.x == 0) *q_slot = (int)atomicAdd(base, 1u);
    __syncthreads();
    const int it = __builtin_amdgcn_readfirstlane(*q_slot);
    __syncthreads();
    if (it >= 1696) break;
    if (it < 256) {
      const int b = it >> 5, g = it & 31;
      ssm_g1_tile(p, smem, l, it);
      __threadfence_block();
      asm volatile("s_waitcnt vmcnt(0)" ::: "memory");
      __syncthreads();
      ssm_y_tile(p, smem, l, b * 64 + g);
      ssm_y_tile(p, smem, l, b * 64 + 32 + g);
      chain_done(base + (1 + b) * 64);
    } else if (it < 288) {
      ssm_g1_tile(p, smem, l, it);
      __threadfence_block();
      asm volatile("s_waitcnt vmcnt(0)" ::: "memory");
      __syncthreads();
      ssm_y_tile(p, smem, l, 512 + (it - 256));
      chain_done(base + 9 * 64);
    } else if (it < 800) {
      attn_prompt_item(p, smem, l, it - 288);
    } else if (it < 1056) {
      attn_sample_item(p, smem, l, it - 800);
    } else if (it < 1568) {
      const int t = it - 1056, mt = t >> 2, nt = t & 3;
      wait_chains(base + (1 + (mt >> 4)) * 64, 32u * 256u);
      glu_tile<4>(p, smem, l, mt * 128, nt * 128);
    } else {
      const int t = it - 1568, mt = t >> 2, nt = t & 3;
      wait_chains(base + 9 * 64, 32u * 256u);
      glu_tile<1>(p, smem, l, NTOK_P + mt * 32, nt * 128);
    }
  }
}

template <int MI>
DI void outproj_tile(const Params& p, char* smem, int l, int m0, int n0) {
  constexpr int BM = 32 * MI;
  const u16* Bt = ((u16*)(WS(p) + W_WT_OUT)) + (size_t)l * 1024 * LDA;
  const u16* A = ((u16*)(WS(p) + W_MIX));
  auto al = [&](int row, int k) { return *(const bf16x8*)(A + (size_t)row * LDA + k); };
  auto ep = [&](const float* Cs) {
    float* out = OUTP(p);
    const float* md = ((float*)(WS(p) + W_MOD));
    for_chunks<BM>([&](int row, int c8) {
      const int m = m0 + row, col = n0 + c8;
      float v[8], gt[8], xo[8];
      ld8(Cs + row * 132 + c8, v);
      ld8(md + ((size_t)l * NROWS_C + brow_of(m)) * 3072 + 2048 + col, gt);
      ld8((l == 0) ? xrow_in(p, m) + col : out + (size_t)m * D + col, xo);
#pragma unroll
      for (int e = 0; e < 8; ++e) v[e] = xo[e] + gt[e] * v[e];
      st8(out + (size_t)m * D + col, v);
    });
  };
  gemm_tile<MI>((u16*)smem, m0, n0, 1024, al, Bt, LDA, 1 << 30, 0, ep);
}
DI void phase_outproj(const Params& p, char* smem, int l, int vx, int vj) {
  const int xcd = vx, nxb = gridDim.x >> 3;
  for (int i = vj; i < 16 * 8; i += nxb) outproj_tile<4>(p, smem, l, (xcd * 16 + i / 8) * 128, (i % 8) * 128);
  for (int i = vj; i < 4 * 8; i += nxb) outproj_tile<1>(p, smem, l, NTOK_P + (xcd * 4 + i / 8) * 32, (i % 8) * 128);
}

DI void phase_final(const Params& p) {
  const int lane = TID() & 63, wid = TID() >> 6;
  for (int m = BID() * 4 + wid; m < NTOK; m += gridDim.x * 4) {
    float* xr = OUTP(p) + (size_t)m * D;
    float4 v[4];
    float ss = 0.f;
#pragma unroll
    for (int i = 0; i < 4; ++i) {
      v[i] = *(const float4*)(xr + lane * 4 + 256 * i);
      ss += v[i].x * v[i].x + v[i].y * v[i].y + v[i].z * v[i].z + v[i].w * v[i].w;
    }
#pragma unroll
    for (int o = 32; o > 0; o >>= 1) ss += __shfl_xor(ss, o);
    float rstd = rsqrtf(ss * (1.f / D) + 1e-6f);
#pragma unroll
    for (int i = 0; i < 4; ++i) {
      int c = lane * 4 + 256 * i;
      float4 gg = *(const float4*)(p.final_g + c);
      float4 o = {v[i].x * rstd * gg.x, v[i].y * rstd * gg.y, v[i].z * rstd * gg.z, v[i].w * rstd * gg.w};
      *(float4*)(xr + c) = o;
    }
  }
}

#define XB_TMO      128
#define XB_XCNT(j)  (256  + 64 * (j))
#define XB_XSUB(j)  (1280 + 64 * (j))
#define XB_XGEN(j)  (2304 + 64 * (j))
#define XB_TOP      3328
#define XB_TOPGEN   3392
#define XCD_BAR_WORDS 3456
#define XB_SPIN_CAP (1u << 18)
#define LAS __attribute__((address_space(3)))
DI unsigned xb_ld(unsigned* p)              { return __hip_atomic_load(p, __ATOMIC_RELAXED, __HIP_MEMORY_SCOPE_AGENT); }
DI unsigned xb_add(unsigned* p, unsigned v) { return __hip_atomic_fetch_add(p, v, __ATOMIC_RELAXED, __HIP_MEMORY_SCOPE_AGENT); }
DI unsigned xb_xcc_id() { return (unsigned)__builtin_amdgcn_s_getreg((3 << 11) | 20) & 0xFu; }
#define XB_SPIN(cond, bar) do { unsigned _sp = 0; while (cond) { __builtin_amdgcn_s_sleep(1); \
    if ((++_sp & 255u) == 0u) { if (xb_ld(&(bar)[XB_TMO])) break; if (_sp > XB_SPIN_CAP) { atomicAdd(&(bar)[XB_TMO], 1u); break; } } } } while (0)
struct XcdBarrier { unsigned* bar; unsigned x; volatile LAS unsigned* st; };
DI XcdBarrier xcd_barrier_post(unsigned* bar, volatile LAS unsigned* st) {
  XcdBarrier b; b.bar = bar; b.x = xb_xcc_id(); b.st = st;
  if (threadIdx.x == 0) st[2] = xb_add(&bar[XB_XCNT(b.x)], 1u);
  return b;
}
DI void xcd_barrier_complete(unsigned* bar, unsigned x, unsigned& nloc, unsigned& nx, unsigned& bal) {
  const unsigned G = gridDim.x * gridDim.y * gridDim.z;
  unsigned sum, cnt, mine, sp = 0u, even;
  for (;;) {
    sum = 0u; cnt = 0u; mine = 0u; even = 1u;
#pragma unroll
    for (unsigned j = 0; j < 16; ++j) { const unsigned c = xb_ld(&bar[XB_XCNT(j)]); sum += c; cnt += (c > 0u) ? 1u : 0u; mine = (j == x) ? c : mine;
      if (c != ((j < 8u) ? (G >> 3) : 0u)) even = 0u; }
    if (sum == G) break;
    __builtin_amdgcn_s_sleep(1);
    if ((++sp & 255u) == 0u) { if (xb_ld(&bar[XB_TMO])) break; if (sp > XB_SPIN_CAP) { atomicAdd(&bar[XB_TMO], 1u); break; } }
  }
  nloc = mine > 0u ? mine : 1u; nx = cnt > 0u ? cnt : 1u;
  bal = (sum == G && even) ? 2u : 1u;
}
DI void xcd_barrier(const XcdBarrier& b) {
  asm volatile("s_waitcnt vmcnt(0)" ::: "memory");
  __syncthreads();
  if (threadIdx.x == 0) {
    unsigned* bar = b.bar;
    __builtin_amdgcn_s_waitcnt(0);
    unsigned nloc = b.st[0], nx = b.st[1];
    if (nloc == 0u) { unsigned bal; xcd_barrier_complete(bar, b.x, nloc, nx, bal); b.st[0] = nloc; b.st[1] = nx; b.st[3] = bal; }
    const unsigned old = xb_add(&bar[XB_XSUB(b.x)], 1u);
    const unsigned gen = old / nloc;
    if (old + 1u == (gen + 1u) * nloc) {
      __builtin_amdgcn_fence(__ATOMIC_RELEASE, "agent");
      asm volatile("s_waitcnt vmcnt(0)" ::: "memory");
      const unsigned og = xb_add(&bar[XB_TOP], 1u);
      const unsigned tg = og / nx;
      if (og + 1u == (tg + 1u) * nx) xb_add(&bar[XB_TOPGEN], 1u);
      else XB_SPIN(xb_ld(&bar[XB_TOPGEN]) == tg, bar);
      __builtin_amdgcn_fence(__ATOMIC_ACQUIRE, "agent");
      xb_add(&bar[XB_XGEN(b.x)], 1u);
      asm volatile("s_waitcnt vmcnt(0)" ::: "memory");
    } else {
      XB_SPIN(xb_ld(&bar[XB_XGEN(b.x)]) == gen, bar);
      __builtin_amdgcn_fence(__ATOMIC_ACQUIRE, "agent");
      asm volatile("s_waitcnt vmcnt(0)" ::: "memory");
    }
  }
  __syncthreads();
}
constexpr int N_PHASES = 1 + 4 * DEPTH + 1;

__global__ void __launch_bounds__(256, 2) fwd_kernel(Params p) {
  __shared__ __attribute__((aligned(16))) char smem[73728];
  __shared__ uint4 xb_words;
  __shared__ int q_slot;
  cg::grid_group grid = cg::this_grid();
  if (threadIdx.x == 0) xb_words = make_uint4(0u, 0u, 0u, 0u);
  __syncthreads();
  XcdBarrier xb = xcd_barrier_post((unsigned*)(p.ws + W_BAR), (volatile LAS unsigned*)&xb_words);
  if (p.phase_lo < 0) grid.sync();
  for (int ph = p.phase_lo; ph < p.phase_hi; ++ph) {
    int vx = BID() & 7, vj = BID() >> 3;
    if (USE_XCC_MAP && xb.st[3] == 2u) { vx = (int)xb.x; vj = (int)xb.st[2]; }
    vx = __builtin_amdgcn_readfirstlane(vx); vj = __builtin_amdgcn_readfirstlane(vj);
    if (ph == 0) phase_prep(p, smem);
    else if (ph == N_PHASES - 1) phase_final(p);
    else {
      int l = (ph - 1) / 4, s = (ph - 1) % 4;
      switch (s) {
        case 0: for (int r = 0; r < REP_NORM; ++r) phase_norm(p, l); break;
        case 1: for (int r = 0; r < REP_INPROJ; ++r) phase_inproj(p, smem, l, vx, vj); break;
        case 2: phase_attn(p, smem, l, &q_slot); break;
        default: phase_outproj(p, smem, l, vx, vj); break;
      }
    }
    if (ph + 1 < p.phase_hi) xcd_barrier(xb);
  }
}

extern "C" void kernel_launch(void* const* d_in, const int* in_sizes, int n_in, void* d_out, int out_size,
                              void* d_ws, size_t ws_size, hipStream_t stream) {
  static int grid_blocks = 0;
  if (!grid_blocks) {
    int dev = 0, cus = 0, per_cu = 0;
    hipGetDevice(&dev);
    hipDeviceGetAttribute(&cus, hipDeviceAttributeMultiprocessorCount, dev);
    hipOccupancyMaxActiveBlocksPerMultiprocessor(&per_cu, fwd_kernel, 256, 0);
    if (per_cu > 2) per_cu = 2;
    if (per_cu < 1) per_cu = 1;
    grid_blocks = cus * per_cu;
  }
  Params p{};
  const float** fp = (const float**)&p;
  for (int i = 0; i < 25; ++i) fp[i] = (const float*)d_in[i];
  p.out = (float*)d_out;
  p.ws = (char*)d_ws;
  if (W_TOTAL > ws_size) fprintf(stderr, "workspace too small: need %zu have %zu\n", (size_t)W_TOTAL, ws_size);
  hipMemsetAsync((char*)d_ws + W_BAR, 0, (size_t)(3456 + 4 * 16 * 64 + 96 * 16) * 4, stream);
  p.phase_lo = 0; p.phase_hi = N_PHASES;
  void* args[] = {&p};
  hipError_t e = hipLaunchCooperativeKernel((void*)fwd_kernel, dim3(grid_blocks), dim3(256), args, 0, stream);
  if (e != hipSuccess) fprintf(stderr, "cooperative launch failed: %s (grid %d)\n", hipGetErrorString(e), grid_blocks);
}
```

```cpp
#include <hip/hip_runtime.h>
#include <hip/hip_cooperative_groups.h>
#include <cstdio>
namespace cg = cooperative_groups;


#define USE_XCC_MAP 0
#define REP_PREP 1
#define REP_MOD 1
#define REP_NORM 1
#define REP_INPROJ 1
#define REP_ATTN 1
#define REP_GLU 1
#define REP_OUT0 1
typedef unsigned short u16;
using bf16x8 = __attribute__((ext_vector_type(8))) short;
using s16x4  = __attribute__((ext_vector_type(4))) short;
using f32x4  = __attribute__((ext_vector_type(4))) float;
using f32x16 = __attribute__((ext_vector_type(16))) float;
using u32x2  = __attribute__((ext_vector_type(2))) unsigned;
using u32x4  = __attribute__((ext_vector_type(4))) unsigned;
typedef __bf16 bf16_2 __attribute__((ext_vector_type(2)));
typedef float float_2 __attribute__((ext_vector_type(2)));
#define DI __device__ __forceinline__

constexpr int D = 1024, NB = 8, SEQ = 2048, DEPTH = 4, DB = 128, DS = 8;
constexpr int NTOK_P = NB * SEQ;
constexpr int NTOK = NTOK_P + DB * DS;
constexpr int INW = 2304;
constexpr int NROWS_C = NB + DB;
constexpr int PAST = 8192;
constexpr int TCH = 16;
constexpr int NCH_P = NTOK_P / TCH;
constexpr size_t O_KP = 17825792, O_VP = 18350080, O_SRP = 18874368, O_SIP = 18939904,
                 O_KS = 19005440, O_VS = 27394048, O_SRS = 35782656, O_SIS = 36831232;

struct Params {
  const float *x_prompt, *x_sample, *cache_k, *cache_v, *st_re, *st_im, *c_prompt, *c_sample,
      *norm_g, *w_ada, *b_ada, *w_in, *sinks, *a_re, *a_im, *log_dt, *b_re, *b_im, *c_re, *c_im,
      *ssm_d, *w_glu, *b_glu, *w_out, *final_g;
  float* out;
  char* ws;
  int phase_lo, phase_hi;
};
constexpr size_t al256(size_t x) { return (x + 255) & ~(size_t)255; }
constexpr int LDA = 1088;
constexpr int LDH = 576;
constexpr int LDV = 2112;
constexpr int LDB1 = 320;
constexpr int LDB2 = 448;
constexpr size_t W_WT_IN = 0;
constexpr size_t W_WT_GLU = W_WT_IN + al256((size_t)4 * 2304 * LDA * 2);
constexpr size_t W_WT_OUT = W_WT_GLU + al256((size_t)4 * 512 * LDH * 2);
constexpr size_t W_SC = W_WT_OUT + al256((size_t)4 * 1024 * LDA * 2);
constexpr size_t W_MOD = W_SC + al256((size_t)256 * 1024 * 2);
constexpr size_t W_MIX = W_MOD + al256((size_t)4 * NROWS_C * 3072 * 4);
constexpr size_t W_HN = W_MIX;
constexpr size_t W_WT_ADA = W_MIX;
constexpr size_t W_Q = W_MIX + al256((size_t)NTOK * LDA * 2);
constexpr size_t W_YG = W_Q + al256((size_t)NTOK * LDH * 2);
constexpr size_t W_K = W_YG + al256((size_t)NTOK * LDH * 2);
constexpr size_t W_VT = W_K + al256((size_t)NTOK * 128 * 2);
constexpr size_t W_ZA = W_VT + al256(((size_t)NB * 128 * LDV + (size_t)DB * 128 * 8) * 2);
constexpr size_t W_U = W_ZA + al256((size_t)NTOK * LDH * 2);
constexpr size_t W_ZS = W_U + al256((size_t)NTOK * LDH * 2);
constexpr size_t W_BT1 = W_ZS + al256((size_t)NTOK * LDH * 2);
constexpr size_t W_BT2 = W_BT1 + al256((size_t)128 * 128 * LDB1 * 2);
constexpr size_t W_APOW = W_BT2 + al256((size_t)128 * 256 * LDB2 * 2);
constexpr size_t W_CARRY_P = W_APOW + al256((size_t)128 * 256 * 4);
constexpr size_t W_CARRY_S = W_CARRY_P + al256((size_t)NCH_P * 32 * 128 * 2);
constexpr size_t W_ROPE = W_CARRY_S + al256((size_t)DB * 32 * 128 * 2);
constexpr size_t W_BAR = W_ROPE + al256((size_t)2 * 2056 * 8 * 4);
constexpr size_t W_QUEUE = W_BAR + (size_t)3456 * 4;
constexpr size_t W_MODCNT = W_QUEUE + (size_t)4 * 16 * 64 * 4;
constexpr size_t W_TOTAL = W_BAR + al256((size_t)(3456 + 4 * 16 * 64 + 96 * 16) * 4);


DI int TID() { int t = threadIdx.x; asm volatile("" : "+v"(t)); return t; }
DI int BID() { int b = blockIdx.x; asm volatile("" : "+s"(b)); return b; }
DI char* WS(const Params& p) { size_t z = 0; asm volatile("" : "+s"(z)); return p.ws + z; }
DI float* OUTP(const Params& p) { size_t z = 0; asm volatile("" : "+s"(z)); return p.out + z; }

DI unsigned pack2(float a, float b) {
  float_2 f = {a, b};
  bf16_2 r = __builtin_convertvector(f, bf16_2);
  return __builtin_bit_cast(unsigned, r);
}
DI u16 f2bf(float a) { return (u16)(pack2(a, 0.f) & 0xffffu); }
DI float bf2f(u16 v) { return __uint_as_float(((unsigned)v) << 16); }
DI float silu_f(float x) { return x / (1.f + __expf(-x)); }
DI float sigmoid_f(float x) { return 1.f / (1.f + __expf(-x)); }
DI float gelu_tanh(float x) {
  float u = 0.7978845608028654f * (x + 0.044715f * x * x * x);
  return x / (1.f + __expf(-2.f * u));
}
DI const float* xrow_in(const Params& p, int m) {
  return m < NTOK_P ? p.x_prompt + (size_t)m * D : p.x_sample + (size_t)(m - NTOK_P) * D;
}
DI int brow_of(int m) { return m < NTOK_P ? (m >> 11) : NB + ((m - NTOK_P) >> 3); }
template <int MI, class AL, class EP>
DI void gemm_tile(u16* sm, int m0, int n0, int K, AL al, const u16* __restrict__ Bt, int ldb,
                  int bskip_at, int bskip, EP ep) {
  constexpr int BM = 32 * MI;
  u16* As = sm;
  u16* Bs = sm + 2 * BM * 72;
  const int tid = TID(), lane = tid & 63, wid = tid >> 6;
  const int wr = wid >> 1, wc = wid & 1, fr = lane & 15, fq = lane >> 4;
  const int lrow = tid >> 3, lk = (tid & 7) * 8;
  f32x4 acc[MI][4];
#pragma unroll
  for (int m = 0; m < MI; ++m)
#pragma unroll
    for (int n = 0; n < 4; ++n) acc[m][n] = f32x4{0.f, 0.f, 0.f, 0.f};
  bf16x8 pa0[MI], pb0[4], pa1[MI], pb1[4];
  const int nk = K >> 6;
  auto gload = [&](bf16x8* pa, bf16x8* pb, int kt) {
    int k = kt * 64 + lk;
    int kb = k + (k >= bskip_at ? bskip : 0);
#pragma unroll
    for (int i = 0; i < MI; ++i) pa[i] = al(m0 + lrow + 32 * i, k);
#pragma unroll
    for (int i = 0; i < 4; ++i) pb[i] = *(const bf16x8*)(Bt + (size_t)(n0 + lrow + 32 * i) * ldb + kb);
  };
  auto lstore = [&](const bf16x8* pa, const bf16x8* pb, int buf) {
#pragma unroll
    for (int i = 0; i < MI; ++i) *(bf16x8*)(As + buf * BM * 72 + (lrow + 32 * i) * 72 + lk) = pa[i];
#pragma unroll
    for (int i = 0; i < 4; ++i) *(bf16x8*)(Bs + buf * 9216 + (lrow + 32 * i) * 72 + lk) = pb[i];
  };
  auto compute = [&](int cur) {
    const u16* Ac = As + cur * BM * 72 + (wr * MI * 16 + fr) * 72 + fq * 8;
    const u16* Bc = Bs + cur * 9216 + (wc * 64 + fr) * 72 + fq * 8;
    bf16x8 af[2][MI], bv[2][4];
#pragma unroll
    for (int kk = 0; kk < 2; ++kk) {
#pragma unroll
      for (int n = 0; n < 4; ++n) bv[kk][n] = *(const bf16x8*)(Bc + n * 16 * 72 + kk * 32);
#pragma unroll
      for (int m = 0; m < MI; ++m) af[kk][m] = *(const bf16x8*)(Ac + m * 16 * 72 + kk * 32);
    }
    __builtin_amdgcn_sched_barrier(0);
#pragma unroll
    for (int kk = 0; kk < 2; ++kk)
#pragma unroll
      for (int m = 0; m < MI; ++m)
#pragma unroll
        for (int n = 0; n < 4; ++n)
          acc[m][n] = __builtin_amdgcn_mfma_f32_16x16x32_bf16(af[kk][m], bv[kk][n], acc[m][n], 0, 0, 0);
    __builtin_amdgcn_sched_barrier(0);
  };
  gload(pa0, pb0, 0);
  gload(pa1, pb1, 1);
  lstore(pa0, pb0, 0);
  __syncthreads();
  int kt = 0;
  for (; kt + 2 < nk; kt += 2) {
    gload(pa0, pb0, kt + 2);
    compute(0);
    lstore(pa1, pb1, 1);
    __syncthreads();
    gload(pa1, pb1, kt + 3);
    compute(1);
    lstore(pa0, pb0, 0);
    __syncthreads();
  }
  compute(0);
  lstore(pa1, pb1, 1);
  __syncthreads();
  compute(1);
  __syncthreads();
  float* Cs = (float*)sm;
#pragma unroll
  for (int m = 0; m < MI; ++m)
#pragma unroll
    for (int n = 0; n < 4; ++n)
#pragma unroll
      for (int j = 0; j < 4; ++j)
        Cs[(wr * MI * 16 + m * 16 + fq * 4 + j) * 132 + wc * 64 + n * 16 + fr] = acc[m][n][j];
  __syncthreads();
  ep(Cs);
  __syncthreads();
}
template <int BM, class F>
DI void for_chunks(F f) {
  const int tid = TID();
#pragma unroll 2
  for (int it = 0; it < BM / 16; ++it) {
    int idx = tid + 256 * it;
    f(idx >> 4, (idx & 15) * 8);
  }
}
DI void ld8(const float* s, float* v) {
  float4 a = *(const float4*)s, b = *(const float4*)(s + 4);
  v[0] = a.x; v[1] = a.y; v[2] = a.z; v[3] = a.w; v[4] = b.x; v[5] = b.y; v[6] = b.z; v[7] = b.w;
}
DI void st8(float* d, const float* v) {
  *(float4*)d = float4{v[0], v[1], v[2], v[3]};
  *(float4*)(d + 4) = float4{v[4], v[5], v[6], v[7]};
}
DI void st8bf(u16* d, const float* v) {
  u32x4 o = {pack2(v[0], v[1]), pack2(v[2], v[3]), pack2(v[4], v[5]), pack2(v[6], v[7])};
  *(u32x4*)d = o;
}
DI void st8bf_wt(u16* d, const float* v) {
  u32x4 o = {pack2(v[0], v[1]), pack2(v[2], v[3]), pack2(v[4], v[5]), pack2(v[6], v[7])};
  asm volatile("global_store_dwordx4 %0, %1, off sc0 sc1" :: "v"(d), "v"(o) : "memory");
}
DI void ld8bf(const u16* s, float* v) {
  u32x4 o = *(const u32x4*)s;
#pragma unroll
  for (int e = 0; e < 4; ++e) { v[2 * e] = __uint_as_float(o[e] << 16); v[2 * e + 1] = __uint_as_float(o[e] & 0xffff0000u); }
}

DI void chain_done(unsigned* cnt);
DI void wait_chains(unsigned* cnt, unsigned need);
DI void transpose_tile(float* tl, const float* __restrict__ src, int ldn, u16* __restrict__ dst, int ldk, int kt, int nt, unsigned* cnt = nullptr) {
  const int tid = TID();
#pragma unroll
  for (int i = 0; i < 4; ++i) {
    int kk = (tid >> 4) + 16 * i, c4 = (tid & 15) * 4;
    float4 v = *(const float4*)(src + (size_t)(kt * 64 + kk) * ldn + nt * 64 + c4);
    tl[kk * 65 + c4 + 0] = v.x; tl[kk * 65 + c4 + 1] = v.y; tl[kk * 65 + c4 + 2] = v.z; tl[kk * 65 + c4 + 3] = v.w;
  }
  __syncthreads();
  {
    int n = tid >> 2, ks = (tid & 3) * 16;
    u32x4 o0, o1;
#pragma unroll
    for (int e = 0; e < 4; ++e) {
      o0[e] = pack2(tl[(ks + 2 * e) * 65 + n], tl[(ks + 2 * e + 1) * 65 + n]);
      o1[e] = pack2(tl[(ks + 8 + 2 * e) * 65 + n], tl[(ks + 8 + 2 * e + 1) * 65 + n]);
    }
    u16* d = dst + (size_t)(nt * 64 + n) * ldk + kt * 64 + ks;
    if (cnt) {
      asm volatile("global_store_dwordx4 %0, %1, off sc0 sc1" :: "v"(d), "v"(o0) : "memory");
      asm volatile("global_store_dwordx4 %0, %1, off offset:16 sc0 sc1" :: "v"(d), "v"(o1) : "memory");
    } else {
      *(u32x4*)d = o0;
      *(u32x4*)(d + 8) = o1;
    }
  }
  if (cnt) chain_done(cnt); else __syncthreads();
}
DI void ssm_tables(const Params& p, float* sm, int lg, int cq) {
  float* pwr = sm;            float* pwi = pwr + 17 * 64;
  float* bbr = pwi + 17 * 64; float* bbi = bbr + 1024;
  float* cr = bbi + 1024;     float* ci = cr + 1024;
  float* Kt = ci + 1024;
  const int tid = TID();
  const float dt = expf(p.log_dt[lg]);
  const float* are = p.a_re + lg * 64;
  const float* aim = p.a_im + lg * 64;
  for (int idx = tid; idx < 17 * 64; idx += 256) {
    int pp = idx & 63, tau = idx >> 6;
    float mag = expf(are[pp] * dt * (float)tau);
    float sn, cs;
    sincosf(aim[pp] * dt * (float)tau, &sn, &cs);
    pwr[idx] = mag * cs; pwi[idx] = mag * sn;
  }
  {
    int pp = tid >> 2, c0 = (tid & 3) * 4;
    float ar = are[pp], ai = aim[pp];
    float x = ar * dt, y = ai * dt;
    float sn, cs, sh, chh;
    sincosf(y, &sn, &cs);
    sincosf(0.5f * y, &sh, &chh);
    float em1 = expm1f(x);
    float nr = em1 * cs - 2.f * sh * sh;
    float ni = (em1 + 1.f) * sn;
    float den = ar * ar + ai * ai;
    float cre = (nr * ar + ni * ai) / den;
    float cim = (ni * ar - nr * ai) / den;
#pragma unroll
    for (int e = 0; e < 4; ++e) {
      float br = p.b_re[(size_t)lg * 1024 + pp * 16 + c0 + e];
      float bi = p.b_im[(size_t)lg * 1024 + pp * 16 + c0 + e];
      bbr[pp * 16 + c0 + e] = cre * br - cim * bi;
      bbi[pp * 16 + c0 + e] = cre * bi + cim * br;
    }
  }
  for (int idx = tid; idx < 1024; idx += 256) {
    cr[idx] = p.c_re[(size_t)lg * 1024 + idx];
    ci[idx] = p.c_im[(size_t)lg * 1024 + idx];
  }
  __syncthreads();
#pragma unroll 1
  for (int e = tid; e < 1024; e += 256) {
    int tau = e >> 6, cl = (e >> 4) & 3, c2 = e & 15, c = cq * 4 + cl;
    float s = 0.f;
#pragma unroll 8
    for (int pp = 0; pp < 64; ++pp) {
      float wr_ = pwr[tau * 64 + pp], wi_ = pwi[tau * 64 + pp];
      float br = bbr[pp * 16 + c2], bi = bbi[pp * 16 + c2];
      float zr = wr_ * br - wi_ * bi, zi = wr_ * bi + wi_ * br;
      s += cr[c * 64 + pp] * zr - ci[c * 64 + pp] * zi;
    }
    if (tau == 0 && c == c2) s += p.ssm_d[lg * 16 + c];
    Kt[e] = s;
  }
  __syncthreads();
  u16* bt2 = ((u16*)(WS(p) + W_BT2)) + (size_t)lg * 256 * LDB2;
#pragma unroll 1
  for (int r = 0; r < 64; ++r) {
    int t = r >> 2, cl = r & 3, c = cq * 4 + cl, n = t * 16 + c;
    {
      int k = tid, s = k >> 4, c2 = k & 15;
      float v = (s <= t) ? Kt[((t - s) << 6) + (cl << 4) + c2] : 0.f;
      bt2[n * LDB2 + k] = f2bf(v);
    }
    if (tid < 128) {
      int pp = tid & 63;
      float wr_ = pwr[(t + 1) * 64 + pp], wi_ = pwi[(t + 1) * 64 + pp];
      float crr = cr[c * 64 + pp], cii = ci[c * 64 + pp];
      float v = (tid < 64) ? (crr * wr_ - cii * wi_) : -(crr * wi_ + cii * wr_);
      bt2[n * LDB2 + 256 + tid] = f2bf(v);
    }
  }
  u16* bt1 = ((u16*)(WS(p) + W_BT1)) + (size_t)lg * 128 * LDB1;
  {
    int k = tid, s = k >> 4, c = k & 15;
#pragma unroll 4
    for (int r = 0; r < 32; ++r) {
      int n = cq * 32 + r, pp = n & 63;
      float wr_ = pwr[(15 - s) * 64 + pp], wi_ = pwi[(15 - s) * 64 + pp];
      float br = bbr[pp * 16 + c], bi = bbi[pp * 16 + c];
      float v = (n < 64) ? (wr_ * br - wi_ * bi) : (wr_ * bi + wi_ * br);
      bt1[n * LDB1 + k] = f2bf(v);
    }
  }
  if (cq == 0 && tid < 64) {
    float* ap = ((float*)(WS(p) + W_APOW)) + (size_t)lg * 256;
    ap[tid] = pwr[16 * 64 + tid]; ap[64 + tid] = pwi[16 * 64 + tid];
    ap[128 + tid] = pwr[8 * 64 + tid]; ap[192 + tid] = pwi[8 * 64 + tid];
  }
  __syncthreads();
}

DI void mod_tile(const Params& p, char* smem, int t);
DI void phase_prep(const Params& p, char* smem) {
  const int tid = TID();
  constexpr int N_TAB = 512, N_ROPE = 1, N_SC = 16, N_TR = 6656, N_CP = 1024;
  constexpr int N_MOD = 288;
  constexpr int total = N_TAB + N_ROPE + N_SC + N_TR + N_CP + N_MOD;
  for (int it = BID(); it < total; it += gridDim.x) {
    int i = it;
    if (i < N_TAB) { ssm_tables(p, (float*)smem, i >> 2, i & 3); continue; }
    i -= N_TAB;
    if (i < N_ROPE) {
      for (int e = tid; e < 2056 * 8; e += 256) {
        int pi = e >> 3, j = e & 7;
        float pos = (float)(pi < 2048 ? pi : PAST + (pi - 2048));
        float inv = powf(500000.0f, -(float)j / 8.0f);
        float sn, cs;
        sincosf(pos * inv, &sn, &cs);
        ((float*)(WS(p) + W_ROPE))[e] = cs; ((float*)(WS(p) + W_ROPE))[2056 * 8 + e] = sn;
      }
      continue;
    }
    i -= N_ROPE;
    if (i < N_SC) {
      for (int e = tid; e < 16 * 1024; e += 256) {
        int r = i * 16 + (e >> 10), c = e & 1023;
        float v = 0.f;
        if (r < NB) v = silu_f(p.c_prompt[r * D + c]);
        else if (r < NROWS_C) v = silu_f(p.c_sample[(r - NB) * D + c]);
        ((u16*)(WS(p) + W_SC))[r * D + c] = f2bf(v);
      }
      continue;
    }
    i -= N_SC;
    if (i < N_TR) {
      float* tl = (float*)smem;
      if (i < 3072) { int l = i / 768, rem = i % 768; transpose_tile(tl, p.w_ada + (size_t)l * 1024 * 3072, 3072, ((u16*)(WS(p) + W_WT_ADA)) + (size_t)l * 3072 * LDA, LDA, rem / 48, rem % 48, (unsigned*)(WS(p) + W_MODCNT) + (l * 24 + (rem % 48) / 2) * 16); }
      else if (i < 5376) { int j = i - 3072; int l = j / 576, rem = j % 576; transpose_tile(tl, p.w_in + (size_t)l * 1024 * 2304, 2304, ((u16*)(WS(p) + W_WT_IN)) + (size_t)l * 2304 * LDA, LDA, rem / 36, rem % 36); }
      else if (i < 5632) { int j = i - 5376; int l = j / 64, rem = j % 64; transpose_tile(tl, p.w_glu + (size_t)l * 512 * 512, 512, ((u16*)(WS(p) + W_WT_GLU)) + (size_t)l * 512 * LDH, LDH, rem / 8, rem % 8); }
      else { int j = i - 5632; int l = j / 256, rem = j % 256; transpose_tile(tl, p.w_out + (size_t)l * 1024 * 1024, 1024, ((u16*)(WS(p) + W_WT_OUT)) + (size_t)l * 1024 * LDA, LDA, rem / 16, rem % 16); }
      continue;
    }
    i -= N_TR;
    if (i < N_CP) {
      int which = i >> 9, lb = i & 511;
      const float4* src = (const float4*)((which ? p.cache_v : p.cache_k) + (size_t)lb * 16384 + 8 * 128);
      float4* dst = (float4*)(OUTP(p) + (which ? O_VS : O_KS) + (size_t)lb * 16384);
      for (int e = tid; e < 3840; e += 256) dst[e] = src[e];
      continue;
    }
    i -= N_CP;
    mod_tile(p, smem, i);
  }
}
DI void mod_tile(const Params& p, char* smem, int t) {
  const int mt = t / 96, nt = t % 96;
  const int m0 = mt * 64, n0 = nt * 128;
  const int l = n0 / 3072, cb = n0 - l * 3072;
  wait_chains((unsigned*)(WS(p) + W_MODCNT) + (l * 24 + cb / 128) * 16, 32u * 256u);
  auto al = [&](int row, int k) {
    u32x4 o = {0u, 0u, 0u, 0u};
    if (row < NROWS_C) {
      const float* c = (row < NB) ? p.c_prompt + (size_t)row * D + k : p.c_sample + (size_t)(row - NB) * D + k;
      float4 a = *(const float4*)c, bb = *(const float4*)(c + 4);
      o[0] = pack2(silu_f(a.x), silu_f(a.y)); o[1] = pack2(silu_f(a.z), silu_f(a.w));
      o[2] = pack2(silu_f(bb.x), silu_f(bb.y)); o[3] = pack2(silu_f(bb.z), silu_f(bb.w));
    }
    return __builtin_bit_cast(bf16x8, o);
  };
  auto ep = [&](const float* Cs) {
    float* md = ((float*)(WS(p) + W_MOD));
    for_chunks<64>([&](int row, int c8) {
      int r = m0 + row;
      if (r < NROWS_C) {
        float v[8], b[8];
        ld8(Cs + row * 132 + c8, v);
        ld8(p.b_ada + l * 3072 + cb + c8, b);
#pragma unroll
        for (int e = 0; e < 8; ++e) v[e] += b[e];
        st8(md + ((size_t)l * NROWS_C + r) * 3072 + cb + c8, v);
      }
    });
  };
  gemm_tile<2>((u16*)smem, m0, n0, 1024, al, ((u16*)(WS(p) + W_WT_ADA)), LDA, 1 << 30, 0, ep);
}

DI void phase_norm(const Params& p, int l) {
  const int lane = TID() & 63, wid = TID() >> 6;
  const float* g = p.norm_g + l * D;
  for (int m = BID() * 4 + wid; m < NTOK; m += gridDim.x * 4) {
    const float* xr = (l == 0) ? xrow_in(p, m) : OUTP(p) + (size_t)m * D;
    const float* md = ((float*)(WS(p) + W_MOD)) + ((size_t)l * NROWS_C + brow_of(m)) * 3072;
    float4 v[4];
    float ss = 0.f;
#pragma unroll
    for (int i = 0; i < 4; ++i) {
      v[i] = *(const float4*)(xr + lane * 4 + 256 * i);
      ss += v[i].x * v[i].x + v[i].y * v[i].y + v[i].z * v[i].z + v[i].w * v[i].w;
    }
#pragma unroll
    for (int o = 32; o > 0; o >>= 1) ss += __shfl_xor(ss, o);
    float rstd = rsqrtf(ss * (1.f / D) + 1e-6f);
#pragma unroll
    for (int i = 0; i < 4; ++i) {
      int c = lane * 4 + 256 * i;
      float4 gg = *(const float4*)(g + c);
      float4 sh = *(const float4*)(md + c);
      float4 sc = *(const float4*)(md + 1024 + c);
      float a0 = v[i].x * rstd * gg.x * (1.f + sc.x) + sh.x;
      float a1 = v[i].y * rstd * gg.y * (1.f + sc.y) + sh.y;
      float a2 = v[i].z * rstd * gg.z * (1.f + sc.z) + sh.z;
      float a3 = v[i].w * rstd * gg.w * (1.f + sc.w) + sh.w;
      u32x2 o = {pack2(a0, a1), pack2(a2, a3)};
      *(u32x2*)(((u16*)(WS(p) + W_HN)) + (size_t)m * LDA + c) = o;
    }
  }
}
DI void phase_inproj(const Params& p, char* smem, int l, int vx, int vj) {
  constexpr int NT = INW / 128;
  constexpr int MT = NTOK / 128;
  const u16* Bt = ((u16*)(WS(p) + W_WT_IN)) + (size_t)l * INW * LDA;
  const int xcd = vx, nxb = gridDim.x >> 3;
  constexpr int PW = 9, MX = MT / 8;
  for (int i = vj; i < MX * NT; i += nxb) {
    int panel = i / (MX * PW), r = i - panel * (MX * PW);
    int mt = xcd * MX + r / PW, nt = panel * PW + r % PW;
    const int m0 = mt * 128, n0 = nt * 128;
    const u16* A = ((u16*)(WS(p) + W_HN));
    auto al = [&](int row, int k) { return *(const bf16x8*)(A + (size_t)row * LDA + k); };
    auto ep = [&](const float* Cs) {
      float* out = OUTP(p);
      if (nt < 5) {
        const float* rope = ((float*)(WS(p) + W_ROPE));
        u16* qd = ((u16*)(WS(p) + W_Q));
        u16* kd = ((u16*)(WS(p) + W_K));
        for_chunks<128>([&](int row, int c8) {
          const int m = m0 + row;
          const bool is_p = m < NTOK_P;
          int b, pos, ridx;
          if (is_p) { b = m >> 11; pos = m & 2047; ridx = pos; }
          else { int rr = m - NTOK_P; b = rr >> 3; pos = rr & 7; ridx = 2048 + pos; }
          float v[8];
          const float* c = Cs + row * 132 + c8;
          ld8(c, v);
          const int dd = c8 & 63;
          if (dd < 16) {
            float cs[8], sn[8], o[8];
            ld8(rope + ridx * 8, cs);
            ld8(rope + 2056 * 8 + ridx * 8, sn);
            if (dd == 0) { ld8(c + 8, o);
#pragma unroll
              for (int e = 0; e < 8; ++e) v[e] = v[e] * cs[e] - o[e] * sn[e];
            } else { ld8(c - 8, o);
#pragma unroll
              for (int e = 0; e < 8; ++e) v[e] = v[e] * cs[e] + o[e] * sn[e];
            }
          }
          if (nt < 4) st8bf(qd + (size_t)m * LDH + n0 + c8, v);
          else {
            st8bf(kd + (size_t)m * 128 + c8, v);
            if (is_p) { if (pos >= SEQ - 128) st8(out + O_KP + ((size_t)(l * NB + b) * 128 + (pos - (SEQ - 128))) * 128 + c8, v); }
            else st8(out + O_KS + ((size_t)(l * DB + b) * 128 + 120 + pos) * 128 + c8, v);
          }
        });
      } else if (nt == 5) {
        u16* vT = ((u16*)(WS(p) + W_VT));
        const int tid = TID();
#pragma unroll 2
        for (int it = 0; it < 8; ++it) {
          int idx = tid + 256 * it, col = idx & 127, rg = idx >> 7;
          const int m = m0 + rg * 8;
          float v[8];
#pragma unroll
          for (int e = 0; e < 8; ++e) v[e] = Cs[(rg * 8 + e) * 132 + col];
          if (m < NTOK_P) {
            int b = m >> 11, pos0 = m & 2047;
            st8bf(vT + ((size_t)(b * 128 + col)) * LDV + pos0, v);
            if (pos0 >= SEQ - 128) {
#pragma unroll
              for (int e = 0; e < 8; ++e) out[O_VP + ((size_t)(l * NB + b) * 128 + (pos0 + e - (SEQ - 128))) * 128 + col] = v[e];
            }
          } else {
            int b = (m - NTOK_P) >> 3;
            st8bf(vT + (size_t)NB * 128 * LDV + ((size_t)(b * 128 + col)) * 8, v);
#pragma unroll
            for (int e = 0; e < 8; ++e) out[O_VS + ((size_t)(l * DB + b) * 128 + 120 + e) * 128 + col] = v[e];
          }
        }
      } else {
        u16* dst; int cb;
        if (nt < 10) { dst = ((u16*)(WS(p) + W_ZA)); cb = n0 - 768; }
        else if (nt < 14) { dst = ((u16*)(WS(p) + W_U)); cb = n0 - 1280; }
        else { dst = ((u16*)(WS(p) + W_ZS)); cb = n0 - 1792; }
        const bool is_u = (nt >= 10) && (nt < 14);
        for_chunks<128>([&](int row, int c8) {
          float v[8];
          ld8(Cs + row * 132 + c8, v);
          const int c = cb + c8;
          if (is_u) st8bf(dst + ((size_t)(c >> 4) * NTOK + (m0 + row)) * 16 + (c & 15), v);
          else st8bf(dst + (size_t)(m0 + row) * LDH + c, v);
        });
      }
    };
    gemm_tile<4>((u16*)smem, m0, n0, 1024, al, Bt, LDA, 1 << 30, 0, ep);
  }
}

DI int crow(int i, int h) { return (i & 3) + 8 * (i >> 2) + 4 * h; }

template <bool SAMPLE>
DI void attn_task(const Params& p, int l, const u16* Ks, const u16* Vt, int VS, int koff, int kp0,
                  const u16* qptr, int qp, float sink, int tok_base, int head_base) {
  const int lane = TID() & 63, r = lane & 31, h = lane >> 5;
  bf16x8 qf[4];
#pragma unroll
  for (int s = 0; s < 4; ++s) qf[s] = *(const bf16x8*)(qptr + 16 * s + 8 * h);
  f32x16 sc[5];
#pragma unroll
  for (int t = 0; t < 5; ++t) {
    f32x16 acc;
#pragma unroll
    for (int i = 0; i < 16; ++i) acc[i] = 0.f;
#pragma unroll
    for (int s = 0; s < 4; ++s) {
      bf16x8 a = *(const bf16x8*)(Ks + (koff + t * 32 + r) * 72 + 16 * s + 8 * h);
      acc = __builtin_amdgcn_mfma_f32_32x32x16_bf16(a, qf[s], acc, 0, 0, 0);
    }
    sc[t] = acc;
  }
  float m = sink;
#pragma unroll
  for (int t = 0; t < 5; ++t)
#pragma unroll
    for (int i = 0; i < 16; ++i) {
      int kp = kp0 + koff + t * 32 + crow(i, h);
      int df = qp - kp;
      bool valid = (df >= 0) && (df <= 128) && (kp >= 0);
      float s = valid ? sc[t][i] * 0.125f : -1e30f;
      sc[t][i] = s;
      m = fmaxf(m, s);
    }
  m = fmaxf(m, __shfl_xor(m, 32));
  float lsum = 0.f;
#pragma unroll
  for (int t = 0; t < 5; ++t)
#pragma unroll
    for (int i = 0; i < 16; ++i) {
      float e = __expf(sc[t][i] - m);
      sc[t][i] = e;
      lsum += e;
    }
  lsum += __shfl_xor(lsum, 32);
  float inv = 1.f / (lsum + __expf(sink - m));
  f32x16 o[2];
#pragma unroll
  for (int i = 0; i < 16; ++i) { o[0][i] = 0.f; o[1][i] = 0.f; }
#pragma unroll
  for (int t = 0; t < 5; ++t)
#pragma unroll
    for (int s = 0; s < 2; ++s) {
      u32x4 pk;
#pragma unroll
      for (int e = 0; e < 4; ++e) pk[e] = pack2(sc[t][8 * s + 2 * e], sc[t][8 * s + 2 * e + 1]);
      bf16x8 pa = __builtin_bit_cast(bf16x8, pk);
      int kb = koff + t * 32 + 16 * s + 4 * h;
#pragma unroll
      for (int dt = 0; dt < 2; ++dt) {
        const u16* vp = Vt + (dt * 32 + r) * VS + kb;
        s16x4 lo = *(const s16x4*)vp;
        s16x4 hi = *(const s16x4*)(vp + 8);
        bf16x8 vb = __builtin_shufflevector(lo, hi, 0, 1, 2, 3, 4, 5, 6, 7);
        o[dt] = __builtin_amdgcn_mfma_f32_32x32x16_bf16(pa, vb, o[dt], 0, 0, 0);
      }
    }
  u16 zz[32];
#pragma unroll
  for (int i = 0; i < 16; ++i) {
    int row = crow(i, h);
    int tok, head;
    if (SAMPLE) { tok = tok_base + (row & 7); head = head_base + (row >> 3); }
    else { tok = tok_base + row; head = head_base; }
#pragma unroll
    for (int dt = 0; dt < 2; ++dt) zz[i * 2 + dt] = ((const u16*)(WS(p) + W_ZA))[(size_t)tok * LDH + head * 64 + dt * 32 + r];
  }
#pragma unroll
  for (int i = 0; i < 16; ++i) {
    int row = crow(i, h);
    float iq = __shfl(inv, row);
    int tok, head;
    if (SAMPLE) { tok = tok_base + (row & 7); head = head_base + (row >> 3); }
    else { tok = tok_base + row; head = head_base; }
#pragma unroll
    for (int dt = 0; dt < 2; ++dt) {
      int c = head * 64 + dt * 32 + r;
      float z = bf2f(zz[i * 2 + dt]);
      ((u16*)(WS(p) + W_MIX))[(size_t)tok * LDA + c] = f2bf(o[dt][i] * iq * silu_f(z));
    }
  }
}

DI void attn_prompt_item(const Params& p, char* smem, int l, int it) {
  const int tid = TID(), wid = tid >> 6, lane = tid & 63;
  const int b = it >> 6, h = (it >> 5) & 1, n = (it >> 1) & 15, half = it & 1;
  const int qb = n * 128 + half * 64, kstart = qb - 128;
  u16* Ks = (u16*)smem;
  u16* Vt = Ks + 192 * 72;
  for (int idx = tid; idx < 192 * 8; idx += 256) {
    int key = idx >> 3, ch = idx & 7, pos = kstart + key;
    bf16x8 v = {0, 0, 0, 0, 0, 0, 0, 0};
    if (pos >= 0) v = *(const bf16x8*)(((u16*)(WS(p) + W_K)) + ((size_t)(b * SEQ + pos)) * 128 + h * 64 + ch * 8);
    *(bf16x8*)(Ks + key * 72 + ch * 8) = v;
  }
  for (int idx = tid; idx < 64 * 24; idx += 256) {
    int d = idx / 24, ch = idx - d * 24, pos0 = kstart + ch * 8;
    s16x4 lo = {0, 0, 0, 0}, hi = {0, 0, 0, 0};
    if (pos0 >= 0) {
      const u16* src = ((u16*)(WS(p) + W_VT)) + ((size_t)((b * 2 + h) * 64 + d)) * LDV + pos0;
      lo = *(const s16x4*)src; hi = *(const s16x4*)(src + 4);
    }
    *(s16x4*)(Vt + d * 196 + ch * 8) = lo;
    *(s16x4*)(Vt + d * 196 + ch * 8 + 4) = hi;
  }
  __syncthreads();
  const int head = h * 4 + wid;
  const float sink = p.sinks[l * 8 + head];
#pragma unroll 1
  for (int r = 0; r < 2; ++r) {
    int q0 = qb + r * 32;
    const u16* qptr = ((u16*)(WS(p) + W_Q)) + ((size_t)(b * SEQ + q0 + (lane & 31))) * LDH + head * 64;
    attn_task<false>(p, l, Ks, Vt, 196, r * 32, kstart, qptr, q0 + (lane & 31), sink, b * SEQ + q0, head);
  }
  __syncthreads();
}

DI void attn_sample_item(const Params& p, char* smem, int l, int it) {
  const int tid = TID(), wid = tid >> 6, lane = tid & 63;
  const int b = it >> 1, h = it & 1;
  u16* Ks = (u16*)smem;
  u16* Vt = Ks + 160 * 72;
  const float* ck = p.cache_k + ((size_t)(l * DB + b)) * 16384 + h * 64;
  const float* cv = p.cache_v + ((size_t)(l * DB + b)) * 16384 + h * 64;
  for (int idx = tid; idx < 160 * 16; idx += 256) {
    int key = idx >> 4, c4 = (idx & 15) * 4;
    u32x2 o = {0u, 0u};
    if (key < 128) {
      float4 v = *(const float4*)(ck + (size_t)key * 128 + c4);
      o[0] = pack2(v.x, v.y); o[1] = pack2(v.z, v.w);
    } else if (key < 136) {
      o = *(const u32x2*)(((u16*)(WS(p) + W_K)) + ((size_t)(NTOK_P + b * 8 + key - 128)) * 128 + h * 64 + c4);
    }
    *(u32x2*)(Ks + key * 72 + c4) = o;
  }
  for (int idx = tid; idx < 128 * 16; idx += 256) {
    int key = idx >> 4, c4 = (idx & 15) * 4;
    float4 v = *(const float4*)(cv + (size_t)key * 128 + c4);
    Vt[(c4 + 0) * 164 + key] = f2bf(v.x);
    Vt[(c4 + 1) * 164 + key] = f2bf(v.y);
    Vt[(c4 + 2) * 164 + key] = f2bf(v.z);
    Vt[(c4 + 3) * 164 + key] = f2bf(v.w);
  }
  if (tid < 64) {
    int d = tid;
    const u16* src = ((u16*)(WS(p) + W_VT)) + (size_t)NB * 128 * LDV + ((size_t)((b * 2 + h) * 64 + d)) * 8;
    s16x4 lo = *(const s16x4*)src, hi = *(const s16x4*)(src + 4);
    s16x4 z = {0, 0, 0, 0};
    u16* dst = Vt + d * 164 + 128;
    *(s16x4*)dst = lo; *(s16x4*)(dst + 4) = hi;
#pragma unroll
    for (int e = 2; e < 8; ++e) *(s16x4*)(dst + 4 * e) = z;
  }
  __syncthreads();
  if (wid == 0) {
    int r = lane & 31, g = r >> 3, t = r & 7;
    const u16* qptr = ((u16*)(WS(p) + W_Q)) + ((size_t)(NTOK_P + b * 8 + t)) * LDH + (h * 4 + g) * 64;
    float sink = p.sinks[l * 8 + h * 4 + g];
    attn_task<true>(p, l, Ks, Vt, 164, 0, PAST - 128, qptr, PAST + t, sink, NTOK_P + b * 8, h * 4);
  }
  __syncthreads();
}
DI void ssm_g1_tile(const Params& p, char* smem, int l, int it) {
  const bool smp = it >= 256;
  const int g = smp ? it - 256 : (it & 31);
  const int mt = smp ? 0 : (it >> 5);
  const u16* U = ((u16*)(WS(p) + W_U));
  auto al = [&](int row, int k) {
    int tok = smp ? (NTOK_P + row * 8 + (k >> 4)) : (row * 16 + (k >> 4));
    return *(const bf16x8*)(U + ((size_t)g * NTOK + tok) * 16 + (k & 15));
  };
  const float* ap = ((float*)(WS(p) + W_APOW)) + (size_t)(l * 32 + g) * 256;
  auto ep = [&](const float* Csc) {
    float* Cs = const_cast<float*>(Csc);
    float* out = OUTP(p);
    const int tid = TID();
    if (smp) {
      u16* cr = ((u16*)(WS(p) + W_CARRY_S));
      for_chunks<128>([&](int row, int c8) {
        const int b = row, pp = c8 & 63;
        const bool im = c8 >= 64;
        float s[8], hr[8], hi[8], ar[8], ai[8], o[8];
        ld8(Cs + row * 132 + c8, s);
        size_t si = ((size_t)(l * DB + b) * 32 + g) * 64 + pp;
        ld8(p.st_re + si, hr); ld8(p.st_im + si, hi);
        ld8(ap + 128 + pp, ar); ld8(ap + 192 + pp, ai);
#pragma unroll
        for (int e = 0; e < 8; ++e) o[e] = im ? (ar[e] * hi[e] + ai[e] * hr[e] + s[e]) : (ar[e] * hr[e] - ai[e] * hi[e] + s[e]);
        st8(out + (im ? O_SIS : O_SRS) + si, o);
        st8bf(cr + ((size_t)g * DB + b) * 128 + c8, im ? hi : hr);
      });
    } else {
      const int b = mt;
      const int pp = tid & 63, sg = tid >> 6;
      const float ar = ap[pp], ai = ap[64 + pp];
      float hr = 0.f, hi = 0.f;
#pragma unroll 4
      for (int j = sg * 32; j < sg * 32 + 32; ++j) {
        float sr = Cs[j * 132 + pp], si = Cs[j * 132 + 64 + pp];
        float nr = ar * hr - ai * hi + sr, ni = ar * hi + ai * hr + si;
        hr = nr; hi = ni;
      }
      float pr = ar, pi = ai;
#pragma unroll
      for (int q = 0; q < 5; ++q) { float t = pr * pr - pi * pi; pi = 2.f * pr * pi; pr = t; }
      float* Ls = Cs + 128 * 132;
      Ls[sg * 128 + pp] = hr; Ls[sg * 128 + 64 + pp] = hi;
      __syncthreads();
      float cr_ = 0.f, ci_ = 0.f;
      for (int s2 = 0; s2 < sg; ++s2) {
        float lr = Ls[s2 * 128 + pp], li = Ls[s2 * 128 + 64 + pp];
        float nr = pr * cr_ - pi * ci_ + lr, ni = pr * ci_ + pi * cr_ + li;
        cr_ = nr; ci_ = ni;
      }
      hr = cr_; hi = ci_;
#pragma unroll 4
      for (int j = sg * 32; j < sg * 32 + 32; ++j) {
        float sr = Cs[j * 132 + pp], si = Cs[j * 132 + 64 + pp];
        Cs[j * 132 + pp] = hr; Cs[j * 132 + 64 + pp] = hi;
        float nr = ar * hr - ai * hi + sr, ni = ar * hi + ai * hr + si;
        hr = nr; hi = ni;
      }
      if (sg == 3) {
        out[O_SRP + ((size_t)(l * NB + b) * 32 + g) * 64 + pp] = hr;
        out[O_SIP + ((size_t)(l * NB + b) * 32 + g) * 64 + pp] = hi;
      }
      __syncthreads();
      u16* cr = ((u16*)(WS(p) + W_CARRY_P));
      for_chunks<128>([&](int row, int c8) {
        float v[8];
        ld8(Cs + row * 132 + c8, v);
        st8bf(cr + ((size_t)g * NCH_P + (b * 128 + row)) * 128 + c8, v);
      });
    }
  };
  const u16* Bt = ((u16*)(WS(p) + W_BT1)) + (size_t)(l * 32 + g) * 128 * LDB1 + (smp ? 128 : 0);
  gemm_tile<4>((u16*)smem, mt * 128, 0, smp ? 128 : 256, al, Bt, LDB1, 1 << 30, 0, ep);
}

DI void ssm_y_tile(const Params& p, char* smem, int l, int it) {
  {
    const bool smp = it >= 512;
    int g, mt, nt;
    if (smp) { g = it - 512; mt = 0; nt = 0; }
    else { g = it & 31; nt = (it >> 5) & 1; mt = it >> 6; }
    const int KU = (smp || nt == 0) ? 128 : 256;
    const int m0 = mt * 128, n0 = nt * 128;
    const u16* U = ((u16*)(WS(p) + W_U));
    const u16* CR = smp ? ((u16*)(WS(p) + W_CARRY_S)) : ((u16*)(WS(p) + W_CARRY_P));
    auto al = [&](int row, int k) {
      if (k < KU) {
        int tok = smp ? (NTOK_P + row * 8 + (k >> 4)) : (row * 16 + (k >> 4));
        return *(const bf16x8*)(U + ((size_t)g * NTOK + tok) * 16 + (k & 15));
      } else {
        return *(const bf16x8*)(CR + ((size_t)g * (smp ? DB : NCH_P) + row) * 128 + (k - KU));
      }
    };
    auto ep = [&](const float* Cs) {
      u16* yg = ((u16*)(WS(p) + W_YG));
      for_chunks<128>([&](int row, int c8) {
        int col = n0 + c8, t = col >> 4, c0 = col & 15;
        int tok = smp ? (NTOK_P + (m0 + row) * 8 + t) : ((m0 + row) * 16 + t);
        float v[8];
        ld8(Cs + row * 132 + c8, v);
#pragma unroll
        for (int e = 0; e < 8; ++e) v[e] = gelu_tanh(v[e]);
        st8bf_wt(yg + (size_t)tok * LDH + g * 16 + c0, v);
      });
    };
    const u16* Bt = ((u16*)(WS(p) + W_BT2)) + (size_t)(l * 32 + g) * 256 * LDB2;
    gemm_tile<4>((u16*)smem, m0, n0, KU + 128, al, Bt, LDB2, KU, 256 - KU, ep);
  }
}

template <int MI>
DI void glu_tile(const Params& p, char* smem, int l, int m0, int n0) {
  constexpr int BM = 32 * MI;
  const u16* Bt = ((u16*)(WS(p) + W_WT_GLU)) + (size_t)l * 512 * LDH;
  const u16* A = ((u16*)(WS(p) + W_YG));
  auto al = [&](int row, int k) { return *(const bf16x8*)(A + (size_t)row * LDH + k); };
  auto ep = [&](const float* Cs) {
    const u16* yg = ((u16*)(WS(p) + W_YG));
    const u16* zs = ((u16*)(WS(p) + W_ZS));
    u16* mix = ((u16*)(WS(p) + W_MIX));
    for_chunks<BM>([&](int row, int c8) {
      const int m = m0 + row, col = n0 + c8;
      float v[8], y[8], z[8], bg[8];
      ld8(Cs + row * 132 + c8, v);
      ld8bf(yg + (size_t)m * LDH + col, y);
      ld8bf(zs + (size_t)m * LDH + col, z);
      ld8(p.b_glu + l * 512 + col, bg);
#pragma unroll
      for (int e = 0; e < 8; ++e) v[e] = y[e] * sigmoid_f(v[e] + bg[e]) * silu_f(z[e]);
      st8bf(mix + (size_t)m * LDA + 512 + col, v);
    });
  };
  gemm_tile<MI>((u16*)smem, m0, n0, 512, al, Bt, LDH, 1 << 30, 0, ep);
}
DI void chain_done(unsigned* cnt) {
  asm volatile("s_waitcnt vmcnt(0)" ::: "memory");
  __syncthreads();
  (void)__hip_atomic_fetch_add(cnt, 1u, __ATOMIC_RELAXED, __HIP_MEMORY_SCOPE_AGENT);
}
DI void wait_chains(unsigned* cnt, unsigned need) {
  if (threadIdx.x < 64) {
    unsigned sp = 0;
    for (;;) {
      const unsigned v = (unsigned)__builtin_amdgcn_readfirstlane((int)__hip_atomic_load(cnt, __ATOMIC_RELAXED, __HIP_MEMORY_SCOPE_AGENT));
      if (v >= need) break;
      __builtin_amdgcn_s_sleep(8);
      if (++sp > (1u << 14)) break;
    }
    __builtin_amdgcn_fence(__ATOMIC_ACQUIRE, "agent");
    asm volatile("s_waitcnt vmcnt(0)" ::: "memory");
  }
  __syncthreads();
}

DI void phase_attn(const Params& p, char* smem, int l, int* q_slot) {
  unsigned* base = (unsigned*)(WS(p) + W_QUEUE) + (size_t)l * 16 * 64;
  for (;;) {
    if (threadIdx.x == 0) *q_slot = (int)atomicAdd(base, 1u);
    __syncthreads();
    const int it = __builtin_amdgcn_readfirstlane(*q_slot);
    __syncthreads();
    if (it >= 1696) break;
    if (it < 256) {
      const int b = it >> 5, g = it & 31;
      ssm_g1_tile(p, smem, l, it);
      __threadfence_block();
      asm volatile("s_waitcnt vmcnt(0)" ::: "memory");
      __syncthreads();
      ssm_y_tile(p, smem, l, b * 64 + g);
      ssm_y_tile(p, smem, l, b * 64 + 32 + g);
      chain_done(base + (1 + b) * 64);
    } else if (it < 288) {
      ssm_g1_tile(p, smem, l, it);
      __threadfence_block();
      asm volatile("s_waitcnt vmcnt(0)" ::: "memory");
      __syncthreads();
      ssm_y_tile(p, smem, l, 512 + (it - 256));
      chain_done(base + 9 * 64);
    } else if (it < 800) {
      attn_prompt_item(p, smem, l, it - 288);
    } else if (it < 1056) {
      attn_sample_item(p, smem, l, it - 800);
    } else if (it < 1568) {
      const int t = it - 1056, mt = t >> 2, nt = t & 3;
      wait_chains(base + (1 + (mt >> 4)) * 64, 32u * 256u);
      glu_tile<4>(p, smem, l, mt * 128, nt * 128);
    } else {
      const int t = it - 1568, mt = t >> 2, nt = t & 3;
      wait_chains(base + 9 * 64, 32u * 256u);
      glu_tile<1>(p, smem, l, NTOK_P + mt * 32, nt * 128);
    }
  }
}

template <int MI>
DI void outproj_tile(const Params& p, char* smem, int l, int m0, int n0) {
  constexpr int BM = 32 * MI;
  const u16* Bt = ((u16*)(WS(p) + W_WT_OUT)) + (size_t)l * 1024 * LDA;
  const u16* A = ((u16*)(WS(p) + W_MIX));
  auto al = [&](int row, int k) { return *(const bf16x8*)(A + (size_t)row * LDA + k); };
  auto ep = [&](const float* Cs) {
    float* out = OUTP(p);
    const float* md = ((float*)(WS(p) + W_MOD));
    for_chunks<BM>([&](int row, int c8) {
      const int m = m0 + row, col = n0 + c8;
      float v[8], gt[8], xo[8];
      ld8(Cs + row * 132 + c8, v);
      ld8(md + ((size_t)l * NROWS_C + brow_of(m)) * 3072 + 2048 + col, gt);
      ld8((l == 0) ? xrow_in(p, m) + col : out + (size_t)m * D + col, xo);
#pragma unroll
      for (int e = 0; e < 8; ++e) v[e] = xo[e] + gt[e] * v[e];
      st8(out + (size_t)m * D + col, v);
    });
  };
  gemm_tile<MI>((u16*)smem, m0, n0, 1024, al, Bt, LDA, 1 << 30, 0, ep);
}
DI void phase_outproj(const Params& p, char* smem, int l, int vx, int vj) {
  const int xcd = vx, nxb = gridDim.x >> 3;
  for (int i = vj; i < 16 * 8; i += nxb) outproj_tile<4>(p, smem, l, (xcd * 16 + i / 8) * 128, (i % 8) * 128);
  for (int i = vj; i < 4 * 8; i += nxb) outproj_tile<1>(p, smem, l, NTOK_P + (xcd * 4 + i / 8) * 32, (i % 8) * 128);
}

DI void phase_final(const Params& p) {
  const int lane = TID() & 63, wid = TID() >> 6;
  for (int m = BID() * 4 + wid; m < NTOK; m += gridDim.x * 4) {
    float* xr = OUTP(p) + (size_t)m * D;
    float4 v[4];
    float ss = 0.f;
#pragma unroll
    for (int i = 0; i < 4; ++i) {
      v[i] = *(const float4*)(xr + lane * 4 + 256 * i);
      ss += v[i].x * v[i].x + v[i].y * v[i].y + v[i].z * v[i].z + v[i].w * v[i].w;
    }
#pragma unroll
    for (int o = 32; o > 0; o >>= 1) ss += __shfl_xor(ss, o);
    float rstd = rsqrtf(ss * (1.f / D) + 1e-6f);
#pragma unroll
    for (int i = 0; i < 4; ++i) {
      int c = lane * 4 + 256 * i;
      float4 gg = *(const float4*)(p.final_g + c);
      float4 o = {v[i].x * rstd * gg.x, v[i].y * rstd * gg.y, v[i].z * rstd * gg.z, v[i].w * rstd * gg.w};
      *(float4*)(xr + c) = o;
    }
  }
}

#define XB_TMO      128
#define XB_XCNT(j)  (256  + 64 * (j))
#define XB_XSUB(j)  (1280 + 64 * (j))
#define XB_XGEN(j)  (2304 + 64 * (j))
#define XB_TOP      3328
#define XB_TOPGEN   3392
#define XCD_BAR_WORDS 3456
#define XB_SPIN_CAP (1u << 18)
#define LAS __attribute__((address_space(3)))
DI unsigned xb_ld(unsigned* p)              { return __hip_atomic_load(p, __ATOMIC_RELAXED, __HIP_MEMORY_SCOPE_AGENT); }
DI unsigned xb_add(unsigned* p, unsigned v) { return __hip_atomic_fetch_add(p, v, __ATOMIC_RELAXED, __HIP_MEMORY_SCOPE_AGENT); }
DI unsigned xb_xcc_id() { return (unsigned)__builtin_amdgcn_s_getreg((3 << 11) | 20) & 0xFu; }
#define XB_SPIN(cond, bar) do { unsigned _sp = 0; while (cond) { __builtin_amdgcn_s_sleep(1); \
    if ((++_sp & 255u) == 0u) { if (xb_ld(&(bar)[XB_TMO])) break; if (_sp > XB_SPIN_CAP) { atomicAdd(&(bar)[XB_TMO], 1u); break; } } } } while (0)
struct XcdBarrier { unsigned* bar; unsigned x; volatile LAS unsigned* st; };
DI XcdBarrier xcd_barrier_post(unsigned* bar, volatile LAS unsigned* st) {
  XcdBarrier b; b.bar = bar; b.x = xb_xcc_id(); b.st = st;
  if (threadIdx.x == 0) st[2] = xb_add(&bar[XB_XCNT(b.x)], 1u);
  return b;
}
DI void xcd_barrier_complete(unsigned* bar, unsigned x, unsigned& nloc, unsigned& nx, unsigned& bal) {
  const unsigned G = gridDim.x * gridDim.y * gridDim.z;
  unsigned sum, cnt, mine, sp = 0u, even;
  for (;;) {
    sum = 0u; cnt = 0u; mine = 0u; even = 1u;
#pragma unroll
    for (unsigned j = 0; j < 16; ++j) { const unsigned c = xb_ld(&bar[XB_XCNT(j)]); sum += c; cnt += (c > 0u) ? 1u : 0u; mine = (j == x) ? c : mine;
      if (c != ((j < 8u) ? (G >> 3) : 0u)) even = 0u; }
    if (sum == G) break;
    __builtin_amdgcn_s_sleep(1);
    if ((++sp & 255u) == 0u) { if (xb_ld(&bar[XB_TMO])) break; if (sp > XB_SPIN_CAP) { atomicAdd(&bar[XB_TMO], 1u); break; } }
  }
  nloc = mine > 0u ? mine : 1u; nx = cnt > 0u ? cnt : 1u;
  bal = (sum == G && even) ? 2u : 1u;
}
DI void xcd_barrier(const XcdBarrier& b) {
  asm volatile("s_waitcnt vmcnt(0)" ::: "memory");
  __syncthreads();
  if (threadIdx.x == 0) {
    unsigned* bar = b.bar;
    __builtin_amdgcn_s_waitcnt(0);
    unsigned nloc = b.st[0], nx = b.st[1];
    if (nloc == 0u) { unsigned bal; xcd_barrier_complete(bar, b.x, nloc, nx, bal); b.st[0] = nloc; b.st[1] = nx; b.st[3] = bal; }
    const unsigned old = xb_add(&bar[XB_XSUB(b.x)], 1u);
    const unsigned gen = old / nloc;
    if (old + 1u == (gen + 1u) * nloc) {
      __builtin_amdgcn_fence(__ATOMIC_RELEASE, "agent");
      asm volatile("s_waitcnt vmcnt(0)" ::: "memory");
      const unsigned og = xb_add(&bar[XB_TOP], 1u);
      const unsigned tg = og / nx;
      if (og + 1u == (tg + 1u) * nx) xb_add(&bar[XB_TOPGEN], 1u);
      else XB_SPIN(xb_ld(&bar[XB_TOPGEN]) == tg, bar);
      __builtin_amdgcn_fence(__ATOMIC_ACQUIRE, "agent");
      xb_add(&bar[XB_XGEN(b.x)], 1u);
      asm volatile("s_waitcnt vmcnt(0)" ::: "memory");
    } else {
      XB_SPIN(xb_ld(&bar[XB_XGEN(b.x)]) == gen, bar);
      __builtin_amdgcn_fence(__ATOMIC_ACQUIRE, "agent");
      asm volatile("s_waitcnt vmcnt(0)" ::: "memory");
    }
  }
  __syncthreads();
}
constexpr int N_PHASES = 1 + 4 * DEPTH + 1;

__global__ void __launch_bounds__(256, 2) fwd_kernel(Params p) {
  __shared__ __attribute__((aligned(16))) char smem[73728];
  __shared__ uint4 xb_words;
  __shared__ int q_slot;
  cg::grid_group grid = cg::this_grid();
  if (threadIdx.x == 0) xb_words = make_uint4(0u, 0u, 0u, 0u);
  __syncthreads();
  XcdBarrier xb = xcd_barrier_post((unsigned*)(p.ws + W_BAR), (volatile LAS unsigned*)&xb_words);
  if (p.phase_lo < 0) grid.sync();
  for (int ph = p.phase_lo; ph < p.phase_hi; ++ph) {
    int vx = BID() & 7, vj = BID() >> 3;
    if (USE_XCC_MAP && xb.st[3] == 2u) { vx = (int)xb.x; vj = (int)xb.st[2]; }
    vx = __builtin_amdgcn_readfirstlane(vx); vj = __builtin_amdgcn_readfirstlane(vj);
    if (ph == 0) phase_prep(p, smem);
    else if (ph == N_PHASES - 1) phase_final(p);
    else {
      int l = (ph - 1) / 4, s = (ph - 1) % 4;
      switch (s) {
        case 0: for (int r = 0; r < REP_NORM; ++r) phase_norm(p, l); break;
        case 1: for (int r = 0; r < REP_INPROJ; ++r) phase_inproj(p, smem, l, vx, vj); break;
        case 2: phase_attn(p, smem, l, &q_slot); break;
        default: phase_outproj(p, smem, l, vx, vj); break;
      }
    }
    if (ph + 1 < p.phase_hi) xcd_barrier(xb);
  }
}

extern "C" void kernel_launch(void* const* d_in, const int* in_sizes, int n_in, void* d_out, int out_size,
                              void* d_ws, size_t ws_size, hipStream_t stream) {
  static int grid_blocks = 0;
  if (!grid_blocks) {
    int dev = 0, cus = 0, per_cu = 0;
    hipGetDevice(&dev);
    hipDeviceGetAttribute(&cus, hipDeviceAttributeMultiprocessorCount, dev);
    hipOccupancyMaxActiveBlocksPerMultiprocessor(&per_cu, fwd_kernel, 256, 0);
    if (per_cu > 2) per_cu = 2;
    if (per_cu < 1) per_cu = 1;
    grid_blocks = cus * per_cu;
  }
  Params p{};
  const float** fp = (const float**)&p;
  for (int i = 0; i < 25; ++i) fp[i] = (const float*)d_in[i];
  p.out = (float*)d_out;
  p.ws = (char*)d_ws;
  if (W_TOTAL > ws_size) fprintf(stderr, "workspace too small: need %zu have %zu\n", (size_t)W_TOTAL, ws_size);
  hipMemsetAsync((char*)d_ws + W_BAR, 0, (size_t)(3456 + 4 * 16 * 64 + 96 * 16) * 4, stream);
  p.phase_lo = 0; p.phase_hi = N_PHASES;
  void* args[] = {&p};
  hipError_t e = hipLaunchCooperativeKernel((void*)fwd_kernel, dim3(grid_blocks), dim3(256), args, 0, stream);
  if (e != hipSuccess) fprintf(stderr, "cooperative launch failed: %s (grid %d)\n", hipGetErrorString(e), grid_blocks);
}
```
